# Optimizing an MI355X kernel written in HIP

```python
import jax, jax.numpy as jnp
from jax import lax
import numpy as np

D_MODEL = 1024
BATCH = 4
SEQ = 8192
DEPTH = 2

GRID_W = 64
CTX_LEN = 256
N_MIXERS = 2
RMS_EPS = 1e-6
GLA_HEADS = 4
GLA_DK = D_MODEL // 2
GLA_DV = D_MODEL
GLA_HEAD_K = GLA_DK // GLA_HEADS
GLA_HEAD_V = GLA_DV // GLA_HEADS
GLA_GATE_RANK = 16
GLA_GATE_NORM = 16.0
GLA_CHUNK = 64
GLA_IN = 2 * GLA_DK + 2 * GLA_DV + 2 * GLA_GATE_RANK
LRU_WIDTH = 1280
LRU_BLOCKS = 5
LRU_BLOCK_W = LRU_WIDTH // LRU_BLOCKS
LRU_C = 8.0
CONV_W = 4

kernel_name = "hybrid_gla_rglru_diffusion_trunk"


def rms_norm(x, g):
    xf = x.astype(jnp.float32)
    y = xf * lax.rsqrt(jnp.mean(xf * xf, axis=-1, keepdims=True) + RMS_EPS)
    return (y * g.astype(jnp.float32)).astype(x.dtype)


def modulate(h, shift, scale):
    return h * (1 + scale) + shift


def to_col_major(z, rows):
    b, t, d = z.shape
    return z.reshape(b, rows, GRID_W, d).transpose(0, 2, 1, 3).reshape(b, t, d)


def from_col_major(z, rows):
    b, t, d = z.shape
    return z.reshape(b, GRID_W, rows, d).transpose(0, 2, 1, 3).reshape(b, t, d)


def gla_scan(q, k, v, log_a, s0):
    b, t, h, _ = q.shape
    dv = v.shape[-1]
    n = t // GLA_CHUNK

    def chunks(z):
        return z.reshape(b, n, GLA_CHUNK, h, z.shape[-1]).transpose(1, 0, 3, 2, 4)

    causal = jnp.tril(jnp.ones((GLA_CHUNK, GLA_CHUNK), dtype=bool))[:, :, None]

    def step(state, inp):
        qc, kc, vc, gc = (z.astype(jnp.float32) for z in inp)
        cum = jnp.cumsum(gc, axis=2)
        o_inter = jnp.einsum('bhck,bhkv->bhcv', qc * jnp.exp(cum), state)
        diff = cum[:, :, :, None, :] - cum[:, :, None, :, :]
        decay = jnp.exp(jnp.where(causal, diff, -jnp.inf))
        scores = jnp.einsum('bhijk,bhjk->bhij', qc[:, :, :, None, :] * decay, kc)
        o_intra = jnp.einsum('bhij,bhjv->bhiv', scores, vc)
        last = cum[:, :, -1:, :]
        state = state * jnp.exp(last[:, :, 0, :, None]) + jnp.einsum(
            'bhck,bhcv->bhkv', kc * jnp.exp(last - cum), vc)
        return state, o_inter + o_intra

    s_final, out = lax.scan(step, s0, (chunks(q), chunks(k), chunks(v), chunks(log_a)))
    out = out.transpose(1, 0, 3, 2, 4).reshape(b, t, h, dv)
    return out.astype(q.dtype), s_final


def gla_mixer(h, w_in, wg_f, bg_f, wg_b, bg_b, norm_w, w_out, s0_f, s0_b, need_out):
    bsz, t, _ = h.shape
    proj = h @ w_in
    splits = [GLA_DK, 2 * GLA_DK, 2 * GLA_DK + GLA_DV, 2 * GLA_DK + 2 * GLA_DV,
              2 * GLA_DK + 2 * GLA_DV + GLA_GATE_RANK]
    q, k, v, g, lr_f, lr_b = jnp.split(proj, splits, axis=-1)
    q = q.reshape(bsz, t, GLA_HEADS, GLA_HEAD_K) * (GLA_HEAD_K ** -0.5)
    k = k.reshape(bsz, t, GLA_HEADS, GLA_HEAD_K)
    v = v.reshape(bsz, t, GLA_HEADS, GLA_HEAD_V)

    def log_gate(lr, w, bias):
        z = (lr @ w + bias).astype(jnp.float32)
        return (jax.nn.log_sigmoid(z) / GLA_GATE_NORM).reshape(bsz, t, GLA_HEADS, GLA_HEAD_K)

    o_f, s_f = gla_scan(q, k, v, log_gate(lr_f, wg_f, bg_f), s0_f)
    o_b_rev, s_b = gla_scan(jnp.flip(q, 1), jnp.flip(k, 1), jnp.flip(v, 1),
                            jnp.flip(log_gate(lr_b, wg_b, bg_b), 1), s0_b)
    if not need_out:
        return None, s_f, s_b
    o = rms_norm(o_f + jnp.flip(o_b_rev, 1), norm_w).reshape(bsz, t, GLA_DV)
    y = (o * jax.nn.silu(g)) @ w_out
    return y, s_f, s_b


def centred_dwconv(z, w, bias):
    left = CONV_W // 2
    y = lax.conv_general_dilated(z, w[:, None, :].astype(z.dtype), window_strides=(1,),
                                 padding=[(left, CONV_W - 1 - left)],
                                 dimension_numbers=('NWC', 'WIO', 'NWC'),
                                 feature_group_count=z.shape[-1])
    return y + bias


def rglru_scan(z, w_a, b_a, w_x, b_x, lam, h0):
    bsz, t, _ = z.shape
    zb = z.reshape(bsz, t, LRU_BLOCKS, LRU_BLOCK_W)
    r = jax.nn.sigmoid((jnp.einsum('btnd,nde->btne', zb, w_a).reshape(bsz, t, LRU_WIDTH) + b_a).astype(jnp.float32))
    i = jax.nn.sigmoid((jnp.einsum('btnd,nde->btne', zb, w_x).reshape(bsz, t, LRU_WIDTH) + b_x).astype(jnp.float32))
    log_a = -LRU_C * r * jax.nn.softplus(-lam.astype(jnp.float32))
    a = jnp.exp(log_a)
    u = jnp.sqrt(-jnp.expm1(2.0 * log_a)) * (i * z.astype(jnp.float32))
    u = u.at[:, 0].add(a[:, 0] * h0)

    def combine(lhs, rhs):
        a_l, u_l = lhs
        a_r, u_r = rhs
        return a_l * a_r, a_r * u_l + u_r

    _, hs = lax.associative_scan(combine, (a, u), axis=1)
    return hs, hs[:, -1]


def rglru_mixer(h, w_in, conv_w, conv_b, p_f, p_b, w_out, h0_f, h0_b, need_out):
    proj = h @ w_in
    z, g = jnp.split(proj, [LRU_WIDTH], axis=-1)
    z = centred_dwconv(z, conv_w, conv_b)
    hf, s_f = rglru_scan(z, *p_f, h0_f)
    hb_rev, s_b = rglru_scan(jnp.flip(z, 1), *p_b, h0_b)
    if not need_out:
        return None, s_f, s_b
    y = ((hf + jnp.flip(hb_rev, 1)).astype(h.dtype) * jax.nn.silu(g)) @ w_out
    return y, s_f, s_b


def setup_inputs(seed: int = 0) -> dict:
    key = jax.random.key(seed)
    ks = iter(jax.random.split(key, 40))
    n_gla = (DEPTH + 1) // 2
    n_lru = DEPTH // 2
    D = D_MODEL

    def nrm(shape, std):
        return jax.random.normal(next(ks), shape, jnp.float32) * std

    u = jax.random.uniform(next(ks), (2, n_lru, LRU_WIDTH), jnp.float32, minval=0.9, maxval=0.999)
    a0 = u ** (1.0 / LRU_C)
    lam = jnp.log(a0) - jnp.log1p(-a0)
    bw = LRU_BLOCK_W ** -0.5
    return {
        "x": nrm((BATCH, SEQ, D), 1.0),
        "c": nrm((BATCH, D), 1.0),
        "ctx": nrm((BATCH, CTX_LEN, D), 1.0),
        "c_ctx": nrm((D,), 1.0),
        "ada_w": nrm((DEPTH, D, 3 * D), 0.5 * D ** -0.5),
        "ada_b": nrm((DEPTH, 3 * D), 0.02),
        "norm_pre": 1.0 + nrm((DEPTH, D), 0.05),
        "norm_post": 1.0 + nrm((DEPTH, D), 0.05),
        "gla_w_in": nrm((n_gla, D, GLA_IN), D ** -0.5),
        "gla_wg_f": nrm((n_gla, GLA_GATE_RANK, GLA_DK), GLA_GATE_RANK ** -0.5),
        "gla_bg_f": nrm((n_gla, GLA_DK), 0.5),
        "gla_wg_b": nrm((n_gla, GLA_GATE_RANK, GLA_DK), GLA_GATE_RANK ** -0.5),
        "gla_bg_b": nrm((n_gla, GLA_DK), 0.5),
        "gla_norm": 1.0 + nrm((n_gla, GLA_HEAD_V), 0.05),
        "gla_w_out": nrm((n_gla, GLA_DV, D), GLA_DV ** -0.5),
        "lru_w_in": nrm((n_lru, D, 2 * LRU_WIDTH), D ** -0.5),
        "lru_conv_w": nrm((n_lru, CONV_W, LRU_WIDTH), CONV_W ** -0.5),
        "lru_conv_b": nrm((n_lru, LRU_WIDTH), 0.02),
        "lru_wa_f": nrm((n_lru, LRU_BLOCKS, LRU_BLOCK_W, LRU_BLOCK_W), bw),
        "lru_ba_f": nrm((n_lru, LRU_WIDTH), 0.1),
        "lru_wx_f": nrm((n_lru, LRU_BLOCKS, LRU_BLOCK_W, LRU_BLOCK_W), bw),
        "lru_bx_f": nrm((n_lru, LRU_WIDTH), 0.1),
        "lru_lam_f": lam[0],
        "lru_wa_b": nrm((n_lru, LRU_BLOCKS, LRU_BLOCK_W, LRU_BLOCK_W), bw),
        "lru_ba_b": nrm((n_lru, LRU_WIDTH), 0.1),
        "lru_wx_b": nrm((n_lru, LRU_BLOCKS, LRU_BLOCK_W, LRU_BLOCK_W), bw),
        "lru_bx_b": nrm((n_lru, LRU_WIDTH), 0.1),
        "lru_lam_b": lam[1],
        "lru_w_out": nrm((n_lru, LRU_WIDTH, D), LRU_WIDTH ** -0.5),
    }


def reference(x, c, ctx, c_ctx, ada_w, ada_b, norm_pre, norm_post,
              gla_w_in, gla_wg_f, gla_bg_f, gla_wg_b, gla_bg_b, gla_norm, gla_w_out,
              lru_w_in, lru_conv_w, lru_conv_b, lru_wa_f, lru_ba_f, lru_wx_f, lru_bx_f, lru_lam_f,
              lru_wa_b, lru_ba_b, lru_wx_b, lru_bx_b, lru_lam_b, lru_w_out):
    bsz, seq, _ = x.shape
    rows = seq // GRID_W
    sc = jax.nn.silu(c)
    sc_ctx = jax.nn.silu(c_ctx)
    for i in range(DEPTH):
        last = i == DEPTH - 1
        j = i // N_MIXERS
        mod = sc @ ada_w[i] + ada_b[i]
        mod_c = sc_ctx @ ada_w[i] + ada_b[i]
        sh, scl, gt = jnp.split(mod[:, None, :], 3, axis=-1)
        sh_c, scl_c, gt_c = jnp.split(mod_c, 3, axis=-1)
        h = modulate(rms_norm(x, norm_pre[i]), sh, scl)
        h_c = modulate(rms_norm(ctx, norm_pre[i]), sh_c, scl_c)
        if i % N_MIXERS == 0:
            params = (gla_w_in[j], gla_wg_f[j], gla_bg_f[j], gla_wg_b[j], gla_bg_b[j], gla_norm[j], gla_w_out[j])
            s0 = jnp.zeros((ctx.shape[0], GLA_HEADS, GLA_HEAD_K, GLA_HEAD_V), jnp.float32)
            y_c, s_f, s_b = gla_mixer(h_c, *params, s0, s0, not last)
            y, _, _ = gla_mixer(h, *params, s_f, s_b, True)
        else:
            p_f = (lru_wa_f[j], lru_ba_f[j], lru_wx_f[j], lru_bx_f[j], lru_lam_f[j])
            p_b = (lru_wa_b[j], lru_ba_b[j], lru_wx_b[j], lru_bx_b[j], lru_lam_b[j])
            h0 = jnp.zeros((ctx.shape[0], LRU_WIDTH), jnp.float32)
            y_c, s_f, s_b = rglru_mixer(h_c, lru_w_in[j], lru_conv_w[j], lru_conv_b[j], p_f, p_b,
                                        lru_w_out[j], h0, h0, not last)
            y, _, _ = rglru_mixer(to_col_major(h, rows), lru_w_in[j], lru_conv_w[j], lru_conv_b[j],
                                  p_f, p_b, lru_w_out[j], s_f, s_b, True)
            y = from_col_major(y, rows)
        x = x + gt * rms_norm(y, norm_post[i])
        if not last:
            ctx = ctx + gt_c * rms_norm(y_c, norm_post[i])
    return x
```

```cpp
#include <hip/hip_runtime.h>
#include <hip/hip_cooperative_groups.h>
#include <cstdio>
namespace cg = cooperative_groups;

#ifndef PH_MASK
#define PH_MASK 0xFFFFFF
#endif
#ifndef REP_MASK
#define REP_MASK 0
#endif
#ifndef EXTRA
#define EXTRA 0
#endif
#ifndef MULTI_LAUNCH
#define MULTI_LAUNCH 0
#endif

typedef unsigned short u16;
typedef short bf16x8 __attribute__((ext_vector_type(8)));
typedef float f32x4 __attribute__((ext_vector_type(4)));
typedef float f32x2 __attribute__((ext_vector_type(2)));
typedef unsigned u32x4 __attribute__((ext_vector_type(4)));
typedef unsigned u32x2 __attribute__((ext_vector_type(2)));
typedef __bf16 bfv2 __attribute__((ext_vector_type(2)));
#define LAS __attribute__((address_space(3)))
#define DI __device__ __forceinline__

constexpr int D = 1024, MX = 32768, MC = 1024, M = MX + MC;
constexpr int NCH = M / 64;
constexpr int LW = 1280;
constexpr size_t MiB = 1024 * 1024;
constexpr size_t OFF_Y = 0;
constexpr size_t OFF_R0 = 66 * MiB;
constexpr size_t OFF_R1 = 132 * MiB;
constexpr size_t OFF_R2 = 198 * MiB;
constexpr size_t OFF_R3 = 264 * MiB;
constexpr size_t OFF_R4 = 330 * MiB;
constexpr size_t OFF_VT = 396 * MiB;
constexpr size_t OFF_WT1 = 462 * MiB;
constexpr size_t OFF_WT2 = OFF_WT1 + 7 * MiB;
constexpr size_t OFF_LR = OFF_WT2 + 2 * MiB;
constexpr size_t OFF_EL = OFF_LR + 5 * MiB;
constexpr size_t OFF_MOD = 479 * MiB;
constexpr size_t OFF_WT3 = OFF_MOD + 1 * MiB;
constexpr size_t OFF_WT4 = OFF_WT3 + 5 * MiB;
constexpr size_t OFF_WT5 = OFF_WT4 + 3 * MiB;
constexpr size_t OFF_CA = OFF_WT5 + 3 * MiB;
constexpr size_t OFF_CU = OFF_CA + 6 * MiB;
constexpr size_t OFF_HS = OFF_CU + 6 * MiB;
constexpr size_t OFF_BAR = OFF_HS + 6 * MiB;
constexpr size_t OFF_AU = 66 * MiB;
constexpr size_t OFF_Z = 132 * MiB;
constexpr size_t OFF_G2 = 396 * MiB;
constexpr size_t OFF_Y2 = 66 * MiB;

struct Params {
    const float* in[29];
    float* out;
    unsigned char* ws;
};

template <class T> DI T ntload(const T* p) { return __builtin_nontemporal_load(p); }
template <class T> DI void ntstore(T v, T* p) { __builtin_nontemporal_store(v, p); }
DI float bf2f(u16 b) { return __uint_as_float(((unsigned)b) << 16); }
DI unsigned pk2(float lo, float hi) { f32x2 v = {lo, hi}; bfv2 b = __builtin_convertvector(v, bfv2); return __builtin_bit_cast(unsigned, b); }
DI u16 f2bf(float f) { return (u16)(pk2(f, 0.f) & 0xffffu); }
DI float lo_bf(unsigned w) { return __uint_as_float(w << 16); }
DI float hi_bf(unsigned w) { return __uint_as_float(w & 0xffff0000u); }
DI float wave_sum(float v) {
#pragma unroll
    for (int o = 32; o; o >>= 1) v += __shfl_xor(v, o);
    return v;
}
DI float fexp(float x) { return __builtin_amdgcn_exp2f(x * 1.4426950408889634f); }
DI float flog(float x) { return __builtin_amdgcn_logf(x) * 0.6931471805599453f; }
DI float sigmoid_f(float x) { return __builtin_amdgcn_rcpf(1.f + fexp(-x)); }
DI float silu_f(float x) { return x * sigmoid_f(x); }

namespace pg8 {
constexpr int BM = 256, BK = 64, HALF = 128, HTB = HALF * BK * 2, STAGE_BYTES = 8 * HTB, NXCD = 8, WGM = 8;
DI int lds_byte(int r, int c) { const int st = (r >> 4) * 2 + (c >> 5), rr = r & 15, cc = c & 31, ob = rr * 64 + cc * 2; return st * 1024 + (ob ^ (((ob >> 9) & 1) << 5)); }
DI void stage_rc(int b, int& R, int& C) { const int st = b / 1024, sb = b % 1024, swz = sb ^ (((sb >> 9) & 1) << 5); R = (st >> 1) * 16 + swz / 64; C = (st & 1) * 32 + (swz % 64) / 2; }
DI int perm32(int rho) { const int n = rho >> 4, i = rho & 15; return 8 * (i >> 2) + 4 * n + (i & 3); }
struct Unit { int pm, pn; };
struct Gemm { const u16* A; const u16* Bt; int M, N, K, lda, ldb, a_shift, a_colbytes; };
struct StaticOrder {
    int nM, nN, nwg, G, c;
    DI void init(int M_, int N_, int G_, int c_) { nM = M_ / BM; nN = N_ / BM; nwg = nM * nN; G = G_; c = c_; }
    DI bool next(int i, Unit& u) const {
        const long L = (long)i * G + c; if (L >= nwg) return false;
        int wgid = (int)L; { const int q = nwg / NXCD, r = nwg % NXCD, xcd = wgid % NXCD, off = wgid / NXCD; wgid = (xcd < r ? xcd * (q + 1) : r * (q + 1) + (xcd - r) * q) + off; }
        const int nig = WGM * nN, gid = wgid / nig, fm = gid * WGM, gsz = (nM - fm) < WGM ? (nM - fm) : WGM;
        u.pm = fm + ((wgid % nig) % gsz); u.pn = (wgid % nig) / gsz; return true;
    }
};

template <class Epi>
DI void gemm_phase(LAS unsigned char* lds, const Gemm g, const StaticOrder& S, const Epi& E) {
    const int tid = threadIdx.x, wid = __builtin_amdgcn_readfirstlane(tid >> 6), lane = tid & 63, wr = wid >> 2, wc = wid & 3, fr = lane & 15, fq = lane >> 4;
    const int K = g.K, nt = K / BK;
    unsigned voffA[2], voffB[2];
#pragma unroll
    for (int i = 0; i < 2; ++i) { int R, C; stage_rc(tid * 16 + i * 8192, R, C); const int Rb = Epi::PERM ? ((R & ~31) + perm32(R & 31)) : R;
        voffA[i] = (unsigned)(R * g.lda + C) * 2u; voffB[i] = (unsigned)(Rb * g.ldb + C) * 2u; }
    const size_t kstep = (size_t)(BK * 2);
    const size_t hstepA = (size_t)HALF * g.lda * 2, hstepB = (size_t)HALF * g.ldb * 2;
    const unsigned ldsw = (unsigned)wid * 1024u;
    const int aoff = lds_byte(wr * 64 + fr, fq * 8), boff = lds_byte(wc * 32 + fr, fq * 8);
#define PG8_SA(b, h) (((b) * 2 + (h)) * HTB)
#define PG8_SB(b, h) ((4 + (b) * 2 + (h)) * HTB)
#define PG8_STAGE(bufoff, gbase, voff) do { _Pragma("unroll") for (int _i = 0; _i < 2; ++_i) \
        __builtin_amdgcn_global_load_lds((const unsigned*)((const char*)(gbase) + (voff)[_i]), (LAS unsigned*)(lds + (bufoff) + ldsw + _i * 8192), 16, 0, 0); } while (0)
#define PG8_LDA(dst, b, h) do { _Pragma("unroll") for (int m = 0; m < 4; ++m) _Pragma("unroll") for (int k = 0; k < 2; ++k) dst[m][k] = *(const LAS bf16x8*)(lds + PG8_SA(b, h) + aoff + m * 2048 + k * 1024); } while (0)
#define PG8_LDB(dst, b, h) do { _Pragma("unroll") for (int n = 0; n < 2; ++n) _Pragma("unroll") for (int k = 0; k < 2; ++k) dst[n][k] = *(const LAS bf16x8*)(lds + PG8_SB(b, h) + boff + n * 2048 + k * 1024); } while (0)
#define PG8_MMA(ai, bj, At, Bt) do { __builtin_amdgcn_s_setprio(1); _Pragma("unroll") for (int m = 0; m < 4; ++m) _Pragma("unroll") for (int n = 0; n < 2; ++n) _Pragma("unroll") for (int k = 0; k < 2; ++k) \
        acc[ai][bj][m][n] = __builtin_amdgcn_mfma_f32_16x16x32_bf16(Bt[n][k], At[m][k], acc[ai][bj][m][n], 0, 0, 0); __builtin_amdgcn_s_setprio(0); } while (0)
#define PG8_WAIT_V(n) asm volatile("s_waitcnt vmcnt(" #n ")" ::: "memory")
#define PG8_WAIT_L(n) asm volatile("s_waitcnt lgkmcnt(" #n ")" ::: "memory")
#define PG8_BAR __builtin_amdgcn_s_barrier()
#define PG8_SCHED __builtin_amdgcn_sched_barrier(0)
#define PG8_APTR(u) ((const char*)g.A + (size_t)(u).pm * 2 * hstepA + (size_t)((u).pn >> g.a_shift) * g.a_colbytes)
#define PG8_BPTR(u) ((const char*)g.Bt + (size_t)(u).pn * 2 * hstepB)
    Unit cur, nxt; int ui = 0;
    if (!S.next(0, cur)) return;
    f32x4 acc[2][2][4][2];
#pragma unroll
    for (int a = 0; a < 2; ++a)
#pragma unroll
        for (int b = 0; b < 2; ++b)
#pragma unroll
            for (int m = 0; m < 4; ++m)
#pragma unroll
                for (int n = 0; n < 2; ++n) acc[a][b][m][n] = (f32x4){0.f, 0.f, 0.f, 0.f};
    bf16x8 At[4][2], B0[2][2], B1[2][2];
    const char* cA = PG8_APTR(cur); const char* cB = PG8_BPTR(cur);
    PG8_STAGE(PG8_SB(0, 0), cB, voffB); PG8_STAGE(PG8_SA(0, 0), cA, voffA); PG8_STAGE(PG8_SB(0, 1), cB + hstepB, voffB); PG8_STAGE(PG8_SA(0, 1), cA + hstepA, voffA);
    if (wr == 1) PG8_BAR;
    PG8_WAIT_V(4); PG8_BAR;
    PG8_STAGE(PG8_SB(1, 0), cB + kstep, voffB); PG8_STAGE(PG8_SA(1, 0), cA + kstep, voffA); PG8_STAGE(PG8_SB(1, 1), cB + hstepB + kstep, voffB);
    PG8_WAIT_V(6); PG8_BAR;
    for (;;) {
        const bool has_next = S.next(ui + 1, nxt);
        const char* nA = has_next ? PG8_APTR(nxt) : cA; const char* nB = has_next ? PG8_BPTR(nxt) : cB;
        for (int t = 0; t < nt; t += 2) {
            const bool last = (t == nt - 2);
            const char* a1 = cA + (size_t)(t + 1) * kstep;
            const char* a2 = last ? nA : cA + (size_t)(t + 2) * kstep; const char* b2 = last ? nB : cB + (size_t)(t + 2) * kstep;
            const char* a3 = a2 + kstep; const char* b3 = b2 + kstep;
            PG8_LDB(B0, 0, 0); PG8_SCHED; PG8_LDA(At, 0, 0); PG8_STAGE(PG8_SA(1, 1), a1 + hstepA, voffA);
            PG8_WAIT_L(8); PG8_BAR; PG8_WAIT_L(0); PG8_MMA(0, 0, At, B0); PG8_BAR; PG8_SCHED;
            PG8_LDB(B1, 0, 1); PG8_STAGE(PG8_SB(0, 0), b2, voffB);
            PG8_BAR; PG8_WAIT_L(0); PG8_MMA(0, 1, At, B1); PG8_BAR;
            PG8_LDA(At, 0, 1); PG8_STAGE(PG8_SA(0, 0), a2, voffA);
            PG8_BAR; PG8_WAIT_L(0); PG8_MMA(1, 0, At, B0); PG8_BAR; PG8_SCHED;
            PG8_STAGE(PG8_SB(0, 1), b2 + hstepB, voffB);
            PG8_WAIT_V(6); PG8_BAR; PG8_MMA(1, 1, At, B1); PG8_BAR;
            PG8_LDB(B0, 1, 0); PG8_SCHED; PG8_LDA(At, 1, 0); PG8_STAGE(PG8_SA(0, 1), a2 + hstepA, voffA);
            PG8_WAIT_L(8); PG8_BAR; PG8_WAIT_L(0); PG8_MMA(0, 0, At, B0); PG8_BAR; PG8_SCHED;
            PG8_LDB(B1, 1, 1); PG8_STAGE(PG8_SB(1, 0), b3, voffB);
            PG8_BAR; PG8_WAIT_L(0); PG8_MMA(0, 1, At, B1); PG8_BAR;
            PG8_LDA(At, 1, 1); PG8_STAGE(PG8_SA(1, 0), a3, voffA);
            PG8_BAR; PG8_WAIT_L(0); PG8_MMA(1, 0, At, B0); PG8_BAR; PG8_SCHED;
            PG8_STAGE(PG8_SB(1, 1), b3 + hstepB, voffB);
            PG8_WAIT_V(6); PG8_BAR; PG8_MMA(1, 1, At, B1); PG8_BAR;
        }
        E(acc, cur, wr, wc, fr, fq);
        if (!has_next) break;
#pragma unroll
        for (int a = 0; a < 2; ++a)
#pragma unroll
            for (int b = 0; b < 2; ++b)
#pragma unroll
                for (int m = 0; m < 4; ++m)
#pragma unroll
                    for (int n = 0; n < 2; ++n) acc[a][b][m][n] = (f32x4){0.f, 0.f, 0.f, 0.f};
        cur = nxt; cA = nA; cB = nB; ++ui;
    }
    PG8_WAIT_V(0);
    if (wr == 0) PG8_BAR;
    PG8_BAR;
#undef PG8_SA
#undef PG8_SB
#undef PG8_STAGE
#undef PG8_LDA
#undef PG8_LDB
#undef PG8_MMA
#undef PG8_WAIT_V
#undef PG8_WAIT_L
#undef PG8_BAR
#undef PG8_SCHED
#undef PG8_APTR
#undef PG8_BPTR
}
}
using pg8::Unit;

struct EpiBf16Split {
    static constexpr bool PERM = true;
    u16* base[3]; int split_tiles; int ldc; float* lr; int lr_tile;
    int row_base = 0;
    DI void operator()(const f32x4 (&acc)[2][2][4][2], const Unit& u, int wr, int wc, int fr, int fq) const {
        const int row0 = row_base + u.pm * 256 + wr * 64 + fr;
        if (u.pn == lr_tile) {
            if (wc == 0) {
#pragma unroll
                for (int ai = 0; ai < 2; ++ai)
#pragma unroll
                    for (int m = 0; m < 4; ++m) { float* rp = lr + (size_t)(row0 + ai * 128 + m * 16) * 32 + 8 * fq;
                        *(f32x4*)(rp) = acc[ai][0][m][0]; *(f32x4*)(rp + 4) = acc[ai][0][m][1]; }
            }
            return;
        }
        const int t = u.pn / split_tiles; u16* b = t == 0 ? base[0] : (t == 1 ? base[1] : base[2]);
        const int col0 = (u.pn - t * split_tiles) * 256 + wc * 32 + 8 * fq;
#pragma unroll
        for (int ai = 0; ai < 2; ++ai)
#pragma unroll
            for (int m = 0; m < 4; ++m) { u16* rowp = b + (size_t)(row0 + ai * 128 + m * 16) * ldc + col0;
#pragma unroll
                for (int bj = 0; bj < 2; ++bj) { const f32x4 v0 = acc[ai][bj][m][0], v1 = acc[ai][bj][m][1];
                    u32x4 w; w.x = pk2(v0[0], v0[1]); w.y = pk2(v0[2], v0[3]); w.z = pk2(v1[0], v1[1]); w.w = pk2(v1[2], v1[3]);
                    *(u32x4*)(rowp + bj * 128) = w; } }
    }
};
struct EpiPair {
    static constexpr bool PERM = true;
    unsigned* GA;
    DI void operator()(const f32x4 (&acc)[2][2][4][2], const Unit& u, int wr, int wc, int fr, int fq) const {
        const int blk = u.pn >> 2, dir = (u.pn >> 1) & 1, half = u.pn & 1;
        const int row0 = u.pm * 256 + wr * 64 + fr;
        unsigned* ga = GA + (size_t)dir * M * LW + blk * 256 + half * 128 + wc * 32 + 8 * fq;
#pragma unroll
        for (int ai = 0; ai < 2; ++ai)
#pragma unroll
            for (int m = 0; m < 4; ++m) { unsigned* rp = ga + (size_t)(row0 + ai * 128 + m * 16) * LW;
#pragma unroll
                for (int n = 0; n < 2; ++n) { u32x4 w;
#pragma unroll
                    for (int j = 0; j < 4; ++j) w[j] = pk2(acc[ai][0][m][n][j], acc[ai][1][m][n][j]);
                    *(u32x4*)(rp + 4 * n) = w; } }
    }
};
DI void gate_au(unsigned w, float z, float ba, float bx, float c8, float& a, float& u) {
    const float r = sigmoid_f(lo_bf(w) + ba), ig = sigmoid_f(hi_bf(w) + bx);
    a = fexp(-c8 * r); u = __builtin_amdgcn_sqrtf(fmaxf(1.f - a * a, 0.f)) * ig * z;
}

DI void phase_prep(const Params& p, unsigned char* shm) {
    const int tid = threadIdx.x;
    float* scS = (float*)shm;
    float* red = scS + 5 * 1024;
    float* MOD = (float*)(p.ws + OFF_MOD);
    for (int i = tid; i < 5 * 1024; i += 512) { const int v = i >> 10, k = i & 1023; const float cv = v < 4 ? p.in[1][v * 1024 + k] : p.in[3][k]; scS[i] = silu_f(cv); }
    __syncthreads();
    for (int item = blockIdx.x; item < 192; item += gridDim.x) {
        const int layer = item / 96, n0 = (item % 96) * 32, col = tid & 31, kg = tid >> 5;
        float a0 = 0.f, a1 = 0.f, a2 = 0.f, a3 = 0.f, a4 = 0.f;
        const float* w = p.in[4] + (size_t)layer * 1024 * 3072 + n0 + col;
#pragma unroll 16
        for (int kk = 0; kk < 64; ++kk) { const int k = kg * 64 + kk; const float wv = w[(size_t)k * 3072];
            a0 += scS[k] * wv; a1 += scS[1024 + k] * wv; a2 += scS[2048 + k] * wv; a3 += scS[3072 + k] * wv; a4 += scS[4096 + k] * wv; }
        red[(kg * 5 + 0) * 32 + col] = a0; red[(kg * 5 + 1) * 32 + col] = a1; red[(kg * 5 + 2) * 32 + col] = a2; red[(kg * 5 + 3) * 32 + col] = a3; red[(kg * 5 + 4) * 32 + col] = a4;
        __syncthreads();
        if (tid < 160) { const int v = tid >> 5, c2 = tid & 31; float s = 0.f;
#pragma unroll
            for (int q = 0; q < 16; ++q) s += red[(q * 5 + v) * 32 + c2];
            MOD[(layer * 5 + v) * 3072 + n0 + c2] = s + p.in[5][layer * 3072 + n0 + c2]; }
        __syncthreads();
    }
}
DI void phase_transposes(const Params& p, unsigned char* shm, int wgi, int nwg) {
    const int tid = threadIdx.x;
    float* tile = (float*)shm;
    constexpr int T0 = 16 * 49, T1 = T0 + 256, T2 = T1 + 640, T3 = T2 + 320, T4 = T3 + 320;
    for (int tb = wgi; tb < T4; tb += 4 * nwg) {
        const float* src[4]; u16* dst[4]; int sld[4], dld[4], Nn[4], k0[4], n0[4]; bool valid[4];
#pragma unroll
        for (int u = 0; u < 4; ++u) {
            const int tl = tb + u * nwg; valid[u] = tl < T4; const int tc = valid[u] ? tl : 0; int kt, ntl;
            if (tc < T0) { kt = tc / 49; ntl = tc % 49; src[u] = p.in[8]; sld[u] = 3104; Nn[u] = 3104; dst[u] = (u16*)(p.ws + OFF_WT1); dld[u] = 1024; }
            else if (tc < T1) { const int t = tc - T0; kt = t / 16; ntl = t % 16; src[u] = p.in[14]; sld[u] = 1024; Nn[u] = 1024; dst[u] = (u16*)(p.ws + OFF_WT2); dld[u] = 1024; }
            else if (tc < T2) { const int t = tc - T1; kt = t / 40; ntl = t % 40; src[u] = p.in[15]; sld[u] = 2560; Nn[u] = 2560; dst[u] = (u16*)(p.ws + OFF_WT3); dld[u] = 1024; }
            else if (tc < T3) { const int t = tc - T2; kt = t / 16; ntl = t % 16; src[u] = p.in[28]; sld[u] = 1024; Nn[u] = 1024; dst[u] = (u16*)(p.ws + OFF_WT5); dld[u] = 1280; }
            else { const int t = tc - T3; const int j = t >> 3, tt = t & 7; kt = tt >> 1; ntl = tt & 1;
                const int gate = j / 10, rem = j % 10, blk = rem >> 1, half = rem & 1, dir = gate >> 1, isx = gate & 1;
                const float* gp = gate == 0 ? p.in[18] : (gate == 1 ? p.in[20] : (gate == 2 ? p.in[23] : p.in[25]));
                src[u] = gp + blk * 65536 + half * 128; sld[u] = 256; Nn[u] = 128;
                dst[u] = (u16*)(p.ws + OFF_WT4) + (size_t)((blk * 4 + dir * 2 + half) * 256 + isx * 128) * 256; dld[u] = 256; }
            k0[u] = kt * 64; n0[u] = ntl * 64;
        }
        float v[4][8];
#pragma unroll
        for (int u = 0; u < 4; ++u)
#pragma unroll
            for (int i = 0; i < 8; ++i) { const int e = tid + i * 512, kr = e >> 6, nc = e & 63;
                v[u][i] = (n0[u] + nc < Nn[u]) ? src[u][(size_t)(k0[u] + kr) * sld[u] + n0[u] + nc] : 0.f; }
        __syncthreads();
#pragma unroll
        for (int u = 0; u < 4; ++u)
#pragma unroll
            for (int i = 0; i < 8; ++i) { const int e = tid + i * 512, kr = e >> 6, nc = e & 63; tile[u * 4160 + kr * 65 + nc] = v[u][i]; }
        __syncthreads();
#pragma unroll
        for (int u = 0; u < 4; ++u) if (valid[u]) {
#pragma unroll
            for (int i = 0; i < 4; ++i) { const int pi = tid + i * 512, nr = pi >> 5, kc = (pi & 31) * 2;
                if (n0[u] + nr < Nn[u]) *(unsigned*)(dst[u] + (size_t)(n0[u] + nr) * dld[u] + k0[u] + kc) = pk2(tile[u * 4160 + kc * 65 + nr], tile[u * 4160 + (kc + 1) * 65 + nr]); } }
    }
}

DI const float* row_src(const Params& p, int row) { return row < MX ? p.in[0] + (size_t)row * D : p.in[2] + (size_t)(row - MX) * D; }
DI int row_perm(int row) { if (row >= MX) return row; const int b = row >> 13, t = row & 8191; return (b << 13) + (t & 63) * 128 + (t >> 6); }

DI void phase_h0(const Params& p, int wgi, int nwg) {
    const int wave = threadIdx.x >> 6, lane = threadIdx.x & 63;
    const float* MOD = (const float*)(p.ws + OFF_MOD);
    u16* H = (u16*)(p.ws + OFF_R0);
    for (int row = wgi * 16 + wave * 2; row < M; row += nwg * 16) {
        const int vec = row < MX ? row >> 13 : 4;
        const float* mod = MOD + (size_t)vec * 3072;
        f32x4 v[2][4]; float ss[2] = {0.f, 0.f};
#pragma unroll
        for (int r = 0; r < 2; ++r) { const float* src = row_src(p, row + r);
#pragma unroll
            for (int i = 0; i < 4; ++i) v[r][i] = *(const f32x4*)(src + i * 256 + lane * 4); }
#pragma unroll
        for (int r = 0; r < 2; ++r) {
#pragma unroll
            for (int i = 0; i < 4; ++i) ss[r] += v[r][i][0] * v[r][i][0] + v[r][i][1] * v[r][i][1] + v[r][i][2] * v[r][i][2] + v[r][i][3] * v[r][i][3];
            ss[r] = rsqrtf(wave_sum(ss[r]) * (1.f / 1024.f) + 1e-6f); }
#pragma unroll
        for (int i = 0; i < 4; ++i) { const int c = i * 256 + lane * 4;
            const f32x4 g = *(const f32x4*)(p.in[6] + c), sh = *(const f32x4*)(mod + c), sc = *(const f32x4*)(mod + 1024 + c);
#pragma unroll
            for (int r = 0; r < 2; ++r) { float o[4];
#pragma unroll
                for (int j = 0; j < 4; ++j) o[j] = v[r][i][j] * ss[r] * g[j] * (1.f + sc[j]) + sh[j];
                u32x2 w; w.x = pk2(o[0], o[1]); w.y = pk2(o[2], o[3]); *(u32x2*)(H + (size_t)(row + r) * D + c) = w; } }
    }
}

DI void phase_gla_chunk(const Params& p, unsigned char* shm, float* outbuf) {
    const int tid = threadIdx.x, wave = tid >> 6, lane = tid & 63, l15 = lane & 15, lg4 = lane >> 4;
    float* lrS = (float*)shm;
    float* wgS = lrS + 64 * 32;
    float* bgS = wgS + 2 * 16 * 128;
    float* totS = bgS + 256;
    u16* qtS = (u16*)(totS + 512);
    u16* kbS = qtS + 64 * 136;
    u16* PS = kbS + 64 * 136;
    u16* vTS = PS + 64 * 72;
    u16* ktS = vTS + 256 * 72;
    const float* LR = (const float*)(p.ws + OFF_LR);
    const u16* QK = (const u16*)(p.ws + OFF_R1);
    const u16* V = (const u16*)(p.ws + OFF_R2);
    u16* QX = (u16*)(p.ws + OFF_R4);
    u16* KT = (u16*)outbuf;
    u16* VT = (u16*)(p.ws + OFF_VT);
    float* EL = (float*)(p.ws + OFF_EL);
    u16* OINTRA = (u16*)(p.ws + OFF_R0);
    int h_loaded = -1;
    for (int item = blockIdx.x; item < NCH * 4; item += gridDim.x) {
        const int cidx = item >> 2, h = item & 3, row0 = cidx * 64;
        u16 qraw[16], kraw[16], vraw[32]; float lrv[4];
        { const u16* qp = QK + (size_t)(row0 + (tid >> 7) * 16) * D + h * 128 + (tid & 127);
#pragma unroll
          for (int tt = 0; tt < 16; ++tt) { qraw[tt] = qp[(size_t)tt * D]; kraw[tt] = qp[(size_t)tt * D + 512]; }
          const u16* vp = V + (size_t)(row0 + (tid >> 8) * 32) * D + h * 256 + (tid & 255);
#pragma unroll
          for (int t2 = 0; t2 < 32; ++t2) vraw[t2] = vp[(size_t)t2 * D];
#pragma unroll
          for (int i = 0; i < 4; ++i) lrv[i] = LR[(size_t)row0 * 32 + tid + i * 512]; }
        if (h != h_loaded) {
            float wv[8]; float bv = 0.f;
#pragma unroll
            for (int i = 0; i < 8; ++i) { const int e = tid + i * 512, d = e >> 11, r = (e >> 7) & 15, k = e & 127; wv[i] = (d ? p.in[11] : p.in[9])[r * 512 + h * 128 + k]; }
            if (tid < 256) { const int d = tid >> 7, k = tid & 127; bv = (d ? p.in[12] : p.in[10])[h * 128 + k]; }
#pragma unroll
            for (int i = 0; i < 8; ++i) wgS[tid + i * 512] = wv[i];
            if (tid < 256) bgS[tid] = bv;
            h_loaded = h;
        }
#pragma unroll
        for (int i = 0; i < 4; ++i) lrS[tid + i * 512] = lrv[i];
        {
            const int v = tid & 255, th = tid >> 8;
            unsigned pw[16];
#pragma unroll
            for (int t2 = 0; t2 < 16; ++t2) pw[t2] = (unsigned)vraw[2 * t2] | ((unsigned)vraw[2 * t2 + 1] << 16);
#pragma unroll
            for (int q = 0; q < 4; ++q) { const u32x4 w = {pw[4 * q], pw[4 * q + 1], pw[4 * q + 2], pw[4 * q + 3]};
                *(u32x4*)(vTS + v * 72 + th * 32 + q * 8) = w; }
        }
        __syncthreads();
        {
            u16* g = VT + (size_t)(cidx * 4 + h) * 16384;
#pragma unroll
            for (int j = 0; j < 4; ++j) { const int id = tid + j * 512; *(u32x4*)(g + id * 8) = *(const u32x4*)(vTS + (id >> 3) * 72 + (id & 7) * 8); }
        }
        f32x4 pacc[2] = {{0.f, 0.f, 0.f, 0.f}, {0.f, 0.f, 0.f, 0.f}};
#pragma unroll
        for (int dir = 0; dir < 2; ++dir) {
            const int k = tid & 127, tg = tid >> 7;
            float wreg[16];
#pragma unroll
            for (int r = 0; r < 16; ++r) wreg[r] = wgS[(dir * 16 + r) * 128 + k];
            const float bgv = bgS[dir * 128 + k];
            float lg[16];
#pragma unroll
            for (int tt = 0; tt < 16; ++tt) { const int t = tg * 16 + tt; float z = bgv;
#pragma unroll
                for (int r = 0; r < 16; ++r) z += lrS[t * 32 + dir * 16 + r] * wreg[r];
                lg[tt] = -(fmaxf(-z, 0.f) + flog(1.f + fexp(-fabsf(z)))) * (1.f / 16.f); }
            float run = 0.f;
            if (dir == 0) {
#pragma unroll
                for (int tt = 0; tt < 16; ++tt) { run += lg[tt]; lg[tt] = run; }
            } else {
#pragma unroll
                for (int tt = 15; tt >= 0; --tt) { run += lg[tt]; lg[tt] = run; }
            }
            totS[tg * 128 + k] = run;
            __syncthreads();
            float off = 0.f, total = 0.f;
#pragma unroll
            for (int g2 = 0; g2 < 4; ++g2) { const float tv = totS[g2 * 128 + k]; total += tv; if (dir == 0 ? (g2 < tg) : (g2 > tg)) off += tv; }
            unsigned kh[8];
            u16* qx = QX + (size_t)dir * M * 512;
#pragma unroll
            for (int t2 = 0; t2 < 8; ++t2) {
                float khv[2];
#pragma unroll
                for (int e = 0; e < 2; ++e) { const int tt = 2 * t2 + e, t = tg * 16 + tt;
                    const float cum = lg[tt] + off;
                    const float qv = bf2f(qraw[tt]) * 0.08838834764831845f;
                    const float kv = bf2f(kraw[tt]);
                    const u16 qt = f2bf(qv * fexp(cum));
                    qtS[t * 136 + k] = qt;
                    kbS[t * 136 + k] = f2bf(kv * fexp(-cum));
                    khv[e] = kv * fexp(total - cum); }
                kh[t2] = pk2(khv[0], khv[1]);
            }
            { const u32x4 w0 = {kh[0], kh[1], kh[2], kh[3]}, w1 = {kh[4], kh[5], kh[6], kh[7]};
              *(u32x4*)(ktS + k * 72 + tg * 16) = w0; *(u32x4*)(ktS + k * 72 + tg * 16 + 8) = w1; }
            if (tg == 0) EL[((size_t)dir * NCH + cidx) * 512 + h * 128 + k] = fexp(total);
            __syncthreads();
            {
#pragma unroll
                for (int j = 0; j < 2; ++j) { const int id = tid + j * 512;
                    { const int t_ = id >> 4, pc = id & 15, ks_ = pc >> 2, d_ = pc & 3;
                      const u32x2 lo = *(const u32x2*)(qtS + t_ * 136 + ks_ * 32 + 4 * d_), hi = *(const u32x2*)(qtS + t_ * 136 + ks_ * 32 + 16 + 4 * d_);
                      const u32x4 w = {lo.x, lo.y, hi.x, hi.y};
                      *(u32x4*)(qx + (size_t)(row0 + t_) * 512 + h * 128 + pc * 8) = w; }
                    *(u32x4*)(KT + (((size_t)dir * NCH + cidx) * 4 + h) * 8192 + id * 8) = *(const u32x4*)(ktS + (id >> 3) * 72 + (id & 7) * 8); }
            }
#pragma unroll
            for (int x = 0; x < 2; ++x) { const int id = wave * 2 + x, it = id >> 2, jt = id & 3;
                if (dir == 0 ? (jt <= it) : (jt >= it)) {
                    f32x4 a4 = {0.f, 0.f, 0.f, 0.f};
#pragma unroll
                    for (int ks = 0; ks < 4; ++ks) { const bf16x8 a = *(const bf16x8*)(qtS + (it * 16 + l15) * 136 + ks * 32 + lg4 * 8);
                        const bf16x8 b = *(const bf16x8*)(kbS + (jt * 16 + l15) * 136 + ks * 32 + lg4 * 8);
                        a4 = __builtin_amdgcn_mfma_f32_16x16x32_bf16(a, b, a4, 0, 0, 0); }
#pragma unroll
                    for (int r = 0; r < 4; ++r) { const int i = it * 16 + lg4 * 4 + r, j = jt * 16 + l15;
                        const bool keep = dir == 0 ? (j <= i) : (j >= i); pacc[x][r] += keep ? a4[r] : 0.f; }
                }
            }
            __syncthreads();
        }
#pragma unroll
        for (int x = 0; x < 2; ++x) { const int id = wave * 2 + x, it = id >> 2, jt = id & 3;
#pragma unroll
            for (int r = 0; r < 4; ++r) PS[(it * 16 + lg4 * 4 + r) * 72 + jt * 16 + l15] = f2bf(pacc[x][r]); }
        __syncthreads();
#pragma unroll
        for (int x = 0; x < 2; ++x) { const int vt = wave * 2 + x;
            const bf16x8 av0 = *(const bf16x8*)(vTS + (vt * 16 + l15) * 72 + lg4 * 8), av1 = *(const bf16x8*)(vTS + (vt * 16 + l15) * 72 + 32 + lg4 * 8);
#pragma unroll
            for (int it = 0; it < 4; ++it) {
                const bf16x8 b0 = *(const bf16x8*)(PS + (it * 16 + l15) * 72 + lg4 * 8), b1 = *(const bf16x8*)(PS + (it * 16 + l15) * 72 + 32 + lg4 * 8);
                f32x4 a4 = {0.f, 0.f, 0.f, 0.f};
                a4 = __builtin_amdgcn_mfma_f32_16x16x32_bf16(av0, b0, a4, 0, 0, 0);
                a4 = __builtin_amdgcn_mfma_f32_16x16x32_bf16(av1, b1, a4, 0, 0, 0);
                u32x2 w; w.x = pk2(a4[0], a4[1]); w.y = pk2(a4[2], a4[3]);
                *(u32x2*)(OINTRA + (size_t)(row0 + it * 16 + l15) * D + h * 256 + vt * 16 + lg4 * 4) = w; }
        }
        __syncthreads();
    }
}

template <int MODE> DI void phase_gla_seq(const Params& p, unsigned char* shm, const float* outbuf) {
    const int tid = threadIdx.x, wave = __builtin_amdgcn_readfirstlane(tid >> 6), lane = tid & 63, l15 = lane & 15, lg4 = lane >> 4;
    constexpr int QS_B = 64 * 288, KS_B = 128 * 144, VS_B = 32 * 144, BUF_B = QS_B + KS_B + VS_B + 512;
    constexpr int SF_OFF = 2 * BUF_B, SF_B = 8192;
    const u16* VT = (const u16*)(p.ws + OFF_VT);
    const float* ELb = (const float*)(p.ws + OFF_EL);
#define SEQ_BAR() do { __builtin_amdgcn_fence(__ATOMIC_RELEASE, "workgroup"); __builtin_amdgcn_s_barrier(); __builtin_amdgcn_fence(__ATOMIC_ACQUIRE, "workgroup"); } while (0)
    for (int item0 = blockIdx.x; item0 < 256; item0 += gridDim.x) {
        const int item = (((item0 & 7) * 4 + (item0 >> 6)) << 3) | ((item0 >> 3) & 7);
        const int vs = item & 7, dir = (item >> 3) & 1, h = (item >> 4) & 3, b = item >> 6;
        const unsigned char* QX = (const unsigned char*)((const u16*)(p.ws + OFF_R4) + (size_t)dir * M * 512 + h * 128);
        const unsigned char* KT = (const unsigned char*)((const u16*)outbuf + (size_t)dir * NCH * 4 * 8192 + (size_t)h * 8192);
        const unsigned char* VTb = (const unsigned char*)(VT + (size_t)h * 16384 + vs * 32 * 64);
        const unsigned char* EL = (const unsigned char*)(ELb + (size_t)dir * NCH * 512 + h * 128);
        u16* OI = (u16*)(p.ws + (dir ? OFF_R2 : OFF_R1));
#define SEQ_CIDX(s) ((s) < 4 ? 512 + 4 * b + (dir ? 3 - (s) : (s)) : 128 * b + (dir ? 127 - ((s) - 4) : ((s) - 4)))
        __syncthreads();
        *(u32x4*)(shm + SF_OFF + tid * 16) = (u32x4){0u, 0u, 0u, 0u};
        if (wave >= 4) {
            const int lt = tid - 256;
            unsigned soff[10], doff[10]; int kind[10];
#pragma unroll
            for (int i = 0; i < 10; ++i) { int id = lt + i * 256; if (id > 2335) id = 2335;
                if (id < 1024) { kind[i] = 0; soff[i] = (unsigned)((id >> 4) * 1024 + (id & 15) * 16); doff[i] = (unsigned)((id >> 4) * 288 + (id & 15) * 16); }
                else if (id < 2048) { const int j = id - 1024; kind[i] = 1; soff[i] = (unsigned)(j * 16); doff[i] = (unsigned)(QS_B + (j >> 3) * 144 + (j & 7) * 16); }
                else if (id < 2304) { const int j = id - 2048; kind[i] = 2; soff[i] = (unsigned)(j * 16); doff[i] = (unsigned)(QS_B + KS_B + (j >> 3) * 144 + (j & 7) * 16); }
                else { const int j = id - 2304; kind[i] = 3; soff[i] = (unsigned)(j * 16); doff[i] = (unsigned)(QS_B + KS_B + VS_B + j * 16); } }
            const bool last_valid = (lt + 9 * 256) < 2336;
            u32x4 ra[10], rb[10], rc[10], rd[10];
#define SEQ_LOAD(R, s) do { const int sl_ = (s) < 132 ? (s) : 131; const int ci = SEQ_CIDX(sl_); \
                const unsigned char* b0 = QX + (size_t)ci * 65536; const unsigned char* b1 = KT + (size_t)ci * 65536; \
                const unsigned char* b2 = VTb + (size_t)ci * 131072; const unsigned char* b3 = EL + (size_t)ci * 2048; \
                _Pragma("unroll") for (int i = 0; i < 10; ++i) { const unsigned char* bp = kind[i] == 0 ? b0 : (kind[i] == 1 ? b1 : (kind[i] == 2 ? b2 : b3)); R[i] = *(const u32x4*)(bp + soff[i]); } } while (0)
#define SEQ_STORE(R, bi) do { unsigned char* bb = shm + (bi) * BUF_B; \
                _Pragma("unroll") for (int i = 0; i < 9; ++i) *(u32x4*)(bb + doff[i]) = R[i]; \
                *(u32x4*)(last_valid ? bb + doff[9] : shm + SF_OFF + 2 * SF_B + lt * 16) = R[9]; } while (0)
#define SEQ_STEP(R, s) do { if ((s) + 1 < 132) SEQ_STORE(R, ((s) + 1) & 1); SEQ_LOAD(R, (s) + 5); SEQ_BAR(); } while (0)
            SEQ_LOAD(ra, 0); SEQ_STORE(ra, 0);
            SEQ_LOAD(ra, 1); SEQ_LOAD(rb, 2); SEQ_LOAD(rc, 3); SEQ_LOAD(rd, 4);
            SEQ_BAR();
            for (int s = 0; s < 132; s += 4) { SEQ_STEP(ra, s); SEQ_STEP(rb, s + 1); SEQ_STEP(rc, s + 2); SEQ_STEP(rd, s + 3); }
#undef SEQ_LOAD
#undef SEQ_STORE
#undef SEQ_STEP
        } else if (wave < 2) {
            f32x4 S[8];
#pragma unroll
            for (int i = 0; i < 8; ++i) S[i] = (f32x4){0.f, 0.f, 0.f, 0.f};
            SEQ_BAR();
            for (int s = 0; s < 132; ++s) {
                const unsigned char* bb = shm + (s & 1) * BUF_B;
                bf16x8 ka[8][2], vb[2]; f32x4 el[8];
#pragma unroll
                for (int ts = 0; ts < 2; ++ts) { vb[ts] = *(const bf16x8*)(bb + QS_B + KS_B + (wave * 16 + l15) * 144 + ts * 64 + lg4 * 16);
#pragma unroll
                    for (int kt = 0; kt < 8; ++kt) ka[kt][ts] = *(const bf16x8*)(bb + QS_B + (kt * 16 + l15) * 144 + ts * 64 + lg4 * 16); }
#pragma unroll
                for (int kt = 0; kt < 8; ++kt) el[kt] = *(const f32x4*)(bb + QS_B + KS_B + VS_B + (kt * 16 + lg4 * 4) * 4);
#pragma unroll
                for (int kt = 0; kt < 8; ++kt) S[kt] = S[kt] * el[kt];
#pragma unroll
                for (int ts = 0; ts < 2; ++ts)
#pragma unroll
                    for (int kt = 0; kt < 8; ++kt) S[kt] = __builtin_amdgcn_mfma_f32_16x16x32_bf16(ka[kt][ts], vb[ts], S[kt], 0, 0, 0);
                unsigned char* sfp = shm + SF_OFF + ((s + 1) & 1) * SF_B + wave * 4096 + lane * 16;
#pragma unroll
                for (int ks = 0; ks < 4; ++ks) { u32x4 w; w.x = pk2(S[2 * ks][0], S[2 * ks][1]); w.y = pk2(S[2 * ks][2], S[2 * ks][3]);
                    w.z = pk2(S[2 * ks + 1][0], S[2 * ks + 1][1]); w.w = pk2(S[2 * ks + 1][2], S[2 * ks + 1][3]); *(u32x4*)(sfp + ks * 1024) = w; }
                SEQ_BAR();
            }
        } else {
            const int w2 = wave - 2;
            SEQ_BAR();
            for (int s = 0; s < 132; ++s) {
                const unsigned char* bb = shm + (s & 1) * BUF_B;
                const int cidx = SEQ_CIDX(s);
                const unsigned char* sfp = shm + SF_OFF + (s & 1) * SF_B + w2 * 4096 + lane * 16;
                bf16x8 sf[4]; u32x4 qf[4][4];
#pragma unroll
                for (int ks = 0; ks < 4; ++ks) sf[ks] = *(const bf16x8*)(sfp + ks * 1024);
#pragma unroll
                for (int tt = 0; tt < 4; ++tt)
#pragma unroll
                    for (int ks = 0; ks < 4; ++ks) qf[tt][ks] = *(const u32x4*)(bb + (tt * 16 + l15) * 288 + ks * 64 + lg4 * 16);
                f32x4 a4[4];
#pragma unroll
                for (int tt = 0; tt < 4; ++tt) a4[tt] = (f32x4){0.f, 0.f, 0.f, 0.f};
#pragma unroll
                for (int ks = 0; ks < 4; ++ks)
#pragma unroll
                    for (int tt = 0; tt < 4; ++tt) a4[tt] = __builtin_amdgcn_mfma_f32_16x16x32_bf16(sf[ks], __builtin_bit_cast(bf16x8, qf[tt][ks]), a4[tt], 0, 0, 0);
#pragma unroll
                for (int tt = 0; tt < 4; ++tt) { u32x2 w; w.x = pk2(a4[tt][0], a4[tt][1]); w.y = pk2(a4[tt][2], a4[tt][3]);
                    *(u32x2*)(OI + (size_t)(cidx * 64 + tt * 16 + l15) * D + h * 256 + vs * 32 + w2 * 16 + lg4 * 4) = w; }
                SEQ_BAR();
            }
        }
#undef SEQ_CIDX
    }
#undef SEQ_BAR
}

DI void phase_gla_combine(const Params& p, int row_lo, int row_hi, int wgi, int nwg) {
    const int wave = threadIdx.x >> 6, lane = threadIdx.x & 63;
    const u16* O0 = (const u16*)(p.ws + OFF_R0); const u16* O1 = (const u16*)(p.ws + OFF_R1); const u16* O2 = (const u16*)(p.ws + OFF_R2);
    const u16* G = (const u16*)(p.ws + OFF_R3); u16* A2 = (u16*)(p.ws + OFF_R4);
    const int vc = (lane & 31) * 8;
    const f32x4 gn0 = *(const f32x4*)(p.in[13] + vc), gn1 = *(const f32x4*)(p.in[13] + vc + 4);
    const float gn[8] = {gn0[0], gn0[1], gn0[2], gn0[3], gn1[0], gn1[1], gn1[2], gn1[3]};
    for (int row = row_lo + wgi * 16 + wave * 2; row < row_hi; row += nwg * 16) {
        u32x4 a[2][2], b[2][2], c[2][2], g[2][2];
#pragma unroll
        for (int r = 0; r < 2; ++r)
#pragma unroll
            for (int q = 0; q < 2; ++q) { const size_t o = (size_t)(row + r) * D + q * 512 + lane * 8;
                a[r][q] = ntload((const u32x4*)(O0 + o)); b[r][q] = ntload((const u32x4*)(O1 + o)); c[r][q] = ntload((const u32x4*)(O2 + o)); g[r][q] = ntload((const u32x4*)(G + o)); }
#pragma unroll
        for (int r = 0; r < 2; ++r)
#pragma unroll
            for (int q = 0; q < 2; ++q) {
                float v[8]; float ss = 0.f;
#pragma unroll
                for (int j = 0; j < 4; ++j) { v[2 * j] = lo_bf(a[r][q][j]) + lo_bf(b[r][q][j]) + lo_bf(c[r][q][j]); v[2 * j + 1] = hi_bf(a[r][q][j]) + hi_bf(b[r][q][j]) + hi_bf(c[r][q][j]); }
#pragma unroll
                for (int j = 0; j < 8; ++j) ss += v[j] * v[j];
                ss += __shfl_xor(ss, 1); ss += __shfl_xor(ss, 2); ss += __shfl_xor(ss, 4); ss += __shfl_xor(ss, 8); ss += __shfl_xor(ss, 16);
                const float rstd = rsqrtf(ss * (1.f / 256.f) + 1e-6f);
                u32x4 w;
#pragma unroll
                for (int j = 0; j < 4; ++j) { const float g0 = lo_bf(g[r][q][j]), g1 = hi_bf(g[r][q][j]);
                    w[j] = pk2(v[2 * j] * rstd * gn[2 * j] * silu_f(g0), v[2 * j + 1] * rstd * gn[2 * j + 1] * silu_f(g1)); }
                *(u32x4*)(A2 + (size_t)(row + r) * D + q * 512 + lane * 8) = w;
            }
    }
}

DI void phase_h1(const Params& p, int row_lo, int row_hi, int wgi, int nwg) {
    const int wave = threadIdx.x >> 6, lane = threadIdx.x & 63;
    const float* MOD = (const float*)(p.ws + OFF_MOD);
    const u16* Y = (const u16*)(p.ws + OFF_Y);
    u16* H = (u16*)(p.ws + OFF_R0);
    for (int row = row_lo + wgi * 16 + wave * 2; row < row_hi; row += nwg * 16) {
        const int vec = row < MX ? row >> 13 : 4;
        const float* mod0 = MOD + (size_t)vec * 3072; const float* mod1 = MOD + (size_t)(5 + vec) * 3072;
        f32x4 v[2][4]; u32x2 yy[2][4];
#pragma unroll
        for (int r = 0; r < 2; ++r) { const float* src = row_src(p, row + r);
#pragma unroll
            for (int i = 0; i < 4; ++i) { const int c = i * 256 + lane * 4; v[r][i] = *(const f32x4*)(src + c); yy[r][i] = *(const u32x2*)(Y + (size_t)(row + r) * D + c); } }
        float rsy[2], rstd[2];
        f32x4 y[2][4];
#pragma unroll
        for (int r = 0; r < 2; ++r) { float ssy = 0.f;
#pragma unroll
            for (int i = 0; i < 4; ++i) { y[r][i] = (f32x4){lo_bf(yy[r][i].x), hi_bf(yy[r][i].x), lo_bf(yy[r][i].y), hi_bf(yy[r][i].y)};
                ssy += y[r][i][0] * y[r][i][0] + y[r][i][1] * y[r][i][1] + y[r][i][2] * y[r][i][2] + y[r][i][3] * y[r][i][3]; }
            rsy[r] = rsqrtf(wave_sum(ssy) * (1.f / 1024.f) + 1e-6f); }
        float ss[2] = {0.f, 0.f};
#pragma unroll
        for (int i = 0; i < 4; ++i) { const int c = i * 256 + lane * 4;
            const f32x4 np = *(const f32x4*)(p.in[7] + c), gt = *(const f32x4*)(mod0 + 2048 + c);
#pragma unroll
            for (int r = 0; r < 2; ++r)
#pragma unroll
                for (int j = 0; j < 4; ++j) { v[r][i][j] += gt[j] * (y[r][i][j] * rsy[r] * np[j]); ss[r] += v[r][i][j] * v[r][i][j]; } }
#pragma unroll
        for (int r = 0; r < 2; ++r) rstd[r] = rsqrtf(wave_sum(ss[r]) * (1.f / 1024.f) + 1e-6f);
#pragma unroll
        for (int i = 0; i < 4; ++i) { const int c = i * 256 + lane * 4;
            const f32x4 g = *(const f32x4*)(p.in[6] + 1024 + c), sh = *(const f32x4*)(mod1 + c), sc = *(const f32x4*)(mod1 + 1024 + c);
#pragma unroll
            for (int r = 0; r < 2; ++r) { float o[4];
#pragma unroll
                for (int j = 0; j < 4; ++j) o[j] = v[r][i][j] * rstd[r] * g[j] * (1.f + sc[j]) + sh[j];
                u32x2 w; w.x = pk2(o[0], o[1]); w.y = pk2(o[2], o[3]); *(u32x2*)(H + (size_t)row_perm(row + r) * D + c) = w; } }
    }
}

DI void phase_conv(const Params& p, float* outbuf) {
    const u16* Z = (const u16*)(p.ws + OFF_Z); u16* ZC = (u16*)outbuf;
    const float* cw = p.in[16]; const float* cb = p.in[17];
    const int total = (M / 8) * 160;
    for (int idx = blockIdx.x * 512 + threadIdx.x; idx < total; idx += gridDim.x * 512) {
        const int row0 = (idx / 160) * 8, ch = (idx % 160) * 8;
        const int pos0 = row0 < MX ? (row0 & 8191) : ((row0 - MX) & 255), len = row0 < MX ? 8192 : 256;
        u32x4 z[11];
#pragma unroll
        for (int i = 0; i < 11; ++i) { const int pp = pos0 + i - 2;
            z[i] = (pp >= 0 && pp < len) ? ntload((const u32x4*)(Z + (size_t)(row0 + i - 2) * LW + ch)) : (u32x4){0u, 0u, 0u, 0u}; }
        f32x4 w[4][2], bias[2];
#pragma unroll
        for (int j = 0; j < 4; ++j) { w[j][0] = *(const f32x4*)(cw + j * LW + ch); w[j][1] = *(const f32x4*)(cw + j * LW + ch + 4); }
        bias[0] = *(const f32x4*)(cb + ch); bias[1] = *(const f32x4*)(cb + ch + 4);
#pragma unroll
        for (int r = 0; r < 8; ++r) {
            f32x4 a0 = bias[0], a1 = bias[1];
#pragma unroll
            for (int j = 0; j < 4; ++j) { const u32x4 zz = z[r + j];
                a0[0] += w[j][0][0] * lo_bf(zz.x); a0[1] += w[j][0][1] * hi_bf(zz.x); a0[2] += w[j][0][2] * lo_bf(zz.y); a0[3] += w[j][0][3] * hi_bf(zz.y);
                a1[0] += w[j][1][0] * lo_bf(zz.z); a1[1] += w[j][1][1] * hi_bf(zz.z); a1[2] += w[j][1][2] * lo_bf(zz.w); a1[3] += w[j][1][3] * hi_bf(zz.w); }
            const u32x4 o = {pk2(a0[0], a0[1]), pk2(a0[2], a0[3]), pk2(a1[0], a1[1]), pk2(a1[2], a1[3])};
            *(u32x4*)(ZC + (size_t)(row0 + r) * LW + ch) = o;
        }
    }
}

DI void phase_lru_agg(const Params& p, const float* outbuf) {
    const unsigned* GAf = (const unsigned*)(p.ws + OFF_AU); const unsigned* GAb = GAf + (size_t)M * LW;
    const u16* ZC = (const u16*)outbuf;
    float* CA = (float*)(p.ws + OFF_CA); float* CU = (float*)(p.ws + OFF_CU);
    const int total = NCH * 320 * 2;
    for (int idx = blockIdx.x * 512 + threadIdx.x; idx < total; idx += gridDim.x * 512) {
        const int half = idx & 1, i2 = idx >> 1, c4 = i2 % 320, cidx = i2 / 320, ch = c4 * 4;
        const f32x4 baf = *(const f32x4*)(p.in[19] + ch), bxf = *(const f32x4*)(p.in[21] + ch), lf = *(const f32x4*)(p.in[22] + ch);
        const f32x4 bab = *(const f32x4*)(p.in[24] + ch), bxb = *(const f32x4*)(p.in[26] + ch), lb = *(const f32x4*)(p.in[27] + ch);
        f32x4 c8f, c8b;
#pragma unroll
        for (int j = 0; j < 4; ++j) { c8f[j] = 8.f * flog(1.f + fexp(-lf[j])); c8b[j] = 8.f * flog(1.f + fexp(-lb[j])); }
        const unsigned base = ((unsigned)cidx * 64u + half * 32u) * LW + ch;
        f32x4 Af = {1.f, 1.f, 1.f, 1.f}, Uf = {0.f, 0.f, 0.f, 0.f}, Pb = {1.f, 1.f, 1.f, 1.f}, Ub = {0.f, 0.f, 0.f, 0.f};
        u32x4 gfA[4], gbA[4], gfB[4], gbB[4]; u32x2 zcA[4], zcB[4];
#define AGG_LOAD(GF, GB, ZZ, tb) do { _Pragma("unroll") for (int q = 0; q < 4; ++q) { const unsigned o = base + (unsigned)((tb) * 4 + q) * LW; GF[q] = ntload((const u32x4*)(GAf + o)); GB[q] = ntload((const u32x4*)(GAb + o)); ZZ[q] = *(const u32x2*)(ZC + o); } } while (0)
#define AGG_COMP(GF, GB, ZZ) do { _Pragma("unroll") for (int q = 0; q < 4; ++q) { \
                const float z[4] = {lo_bf(ZZ[q].x), hi_bf(ZZ[q].x), lo_bf(ZZ[q].y), hi_bf(ZZ[q].y)}; \
                _Pragma("unroll") for (int j = 0; j < 4; ++j) { float a, u; \
                    gate_au(GF[q][j], z[j], baf[j], bxf[j], c8f[j], a, u); Uf[j] = a * Uf[j] + u; Af[j] *= a; \
                    gate_au(GB[q][j], z[j], bab[j], bxb[j], c8b[j], a, u); Ub[j] += Pb[j] * u; Pb[j] *= a; } } } while (0)
        AGG_LOAD(gfA, gbA, zcA, 0);
        for (int tb = 0; tb < 8; tb += 2) {
            AGG_LOAD(gfB, gbB, zcB, tb + 1);
            AGG_COMP(gfA, gbA, zcA);
            if (tb + 2 < 8) AGG_LOAD(gfA, gbA, zcA, tb + 2);
            AGG_COMP(gfB, gbB, zcB);
        }
#undef AGG_LOAD
#undef AGG_COMP
        f32x4 Af1, Uf1, Pb1, Ub1;
#pragma unroll
        for (int j = 0; j < 4; ++j) { Af1[j] = __shfl_xor(Af[j], 1); Uf1[j] = __shfl_xor(Uf[j], 1); Pb1[j] = __shfl_xor(Pb[j], 1); Ub1[j] = __shfl_xor(Ub[j], 1); }
        if (half == 0) {
            f32x4 A, U, P, UB;
#pragma unroll
            for (int j = 0; j < 4; ++j) { A[j] = Af[j] * Af1[j]; U[j] = Af1[j] * Uf[j] + Uf1[j]; P[j] = Pb[j] * Pb1[j]; UB[j] = Ub[j] + Pb[j] * Ub1[j]; }
            const size_t o = (size_t)cidx * LW + ch;
            *(f32x4*)(CA + o) = A; *(f32x4*)(CU + o) = U; *(f32x4*)(CA + (size_t)NCH * LW + o) = P; *(f32x4*)(CU + (size_t)NCH * LW + o) = UB;
        }
    }
}
DI void phase_lru_carry(const Params& p) {
    const float* CA = (const float*)(p.ws + OFF_CA); const float* CU = (const float*)(p.ws + OFF_CU); float* HS = (float*)(p.ws + OFF_HS);
    for (int idx = blockIdx.x * 512 + threadIdx.x; idx < 4 * 2 * LW; idx += gridDim.x * 512) {
        const int ch = idx % LW, dir = (idx / LW) & 1, b = idx / (2 * LW);
        float h = 0.f;
        for (int s0 = 0; s0 < 132; s0 += 12) {
            size_t o[12]; float a[12], u[12];
#pragma unroll
            for (int q = 0; q < 12; ++q) { const int s = s0 + q; const int cidx = s < 4 ? 512 + 4 * b + (dir ? 3 - s : s) : 128 * b + (dir ? 127 - (s - 4) : (s - 4));
                o[q] = ((size_t)dir * NCH + cidx) * LW + ch; a[q] = CA[o[q]]; u[q] = CU[o[q]]; }
#pragma unroll
            for (int q = 0; q < 12; ++q) { HS[o[q]] = h; h = a[q] * h + u[q]; }
        }
    }
}
DI void phase_lru_apply(const Params& p, unsigned char* shm, float* outbuf) {
    const int tid = threadIdx.x;
    float* hf = (float*)shm;
    const unsigned* GAf = (const unsigned*)(p.ws + OFF_AU); const unsigned* GAb = GAf + (size_t)M * LW;
    const float* HS = (const float*)(p.ws + OFF_HS);
    const u16* G2 = (const u16*)(p.ws + OFF_G2); u16* ZA = (u16*)outbuf;
    for (int wi = blockIdx.x; wi < 1280; wi += gridDim.x) {
        const int item = wi * 2 + (tid >> 8), cidx = item / 5, ch = (item % 5) * 256 + (tid & 255);
        const unsigned base = (unsigned)cidx * 64u * LW + ch;
        const float baf = p.in[19][ch], bxf = p.in[21][ch], c8f = 8.f * flog(1.f + fexp(-p.in[22][ch]));
        const float bab = p.in[24][ch], bxb = p.in[26][ch], c8b = 8.f * flog(1.f + fexp(-p.in[27][ch]));
        float h = HS[(size_t)cidx * LW + ch];
        const float hb0 = HS[((size_t)NCH + cidx) * LW + ch];
        for (int tb = 0; tb < 2; ++tb) {
            unsigned w[32]; u16 z[32];
#pragma unroll
            for (int q = 0; q < 32; ++q) { const unsigned o = base + (unsigned)(tb * 32 + q) * LW; w[q] = ntload(GAf + o); z[q] = ZA[o]; }
#pragma unroll
            for (int q = 0; q < 32; ++q) { float a, u; gate_au(w[q], bf2f(z[q]), baf, bxf, c8f, a, u); h = a * h + u; hf[(tb * 32 + q) * 512 + tid] = h; }
        }
        h = hb0;
        for (int tb = 3; tb >= 0; --tb) {
            unsigned w[16]; u16 z[16], g[16];
#pragma unroll
            for (int q = 0; q < 16; ++q) { const unsigned o = base + (unsigned)(tb * 16 + q) * LW; w[q] = ntload(GAb + o); z[q] = ntload(ZA + o); g[q] = ntload(G2 + o); }
#pragma unroll
            for (int q = 15; q >= 0; --q) { float a, u; gate_au(w[q], bf2f(z[q]), bab, bxb, c8b, a, u); h = a * h + u;
                const float tot = hf[(tb * 16 + q) * 512 + tid] + h;
                ZA[base + (unsigned)(tb * 16 + q) * LW] = f2bf(tot * silu_f(bf2f(g[q]))); }
        }
    }
}

DI void phase_final(const Params& p) {
    const int wave = threadIdx.x >> 6, lane = threadIdx.x & 63;
    const float* MOD = (const float*)(p.ws + OFF_MOD);
    const u16* Y = (const u16*)(p.ws + OFF_Y); const u16* Y2 = (const u16*)(p.ws + OFF_Y2);
    for (int row = blockIdx.x * 16 + wave * 2; row < MX; row += gridDim.x * 16) {
        const int vec = row >> 13;
        const float* gt0 = MOD + (size_t)vec * 3072 + 2048; const float* gt1 = MOD + (size_t)(5 + vec) * 3072 + 2048;
        f32x4 v[2][4]; u32x2 yy[2][4], zz[2][4];
#pragma unroll
        for (int r = 0; r < 2; ++r) { const float* src = p.in[0] + (size_t)(row + r) * D; const size_t prow = (size_t)row_perm(row + r);
#pragma unroll
            for (int i = 0; i < 4; ++i) { const int c = i * 256 + lane * 4; v[r][i] = ntload((const f32x4*)(src + c));
                yy[r][i] = ntload((const u32x2*)(Y + (size_t)(row + r) * D + c)); zz[r][i] = ntload((const u32x2*)(Y2 + prow * D + c)); } }
        f32x4 y[2][4], y2[2][4]; float rsy[2], rs2[2];
#pragma unroll
        for (int r = 0; r < 2; ++r) { float ssy = 0.f, ss2 = 0.f;
#pragma unroll
            for (int i = 0; i < 4; ++i) { y[r][i] = (f32x4){lo_bf(yy[r][i].x), hi_bf(yy[r][i].x), lo_bf(yy[r][i].y), hi_bf(yy[r][i].y)};
                y2[r][i] = (f32x4){lo_bf(zz[r][i].x), hi_bf(zz[r][i].x), lo_bf(zz[r][i].y), hi_bf(zz[r][i].y)};
#pragma unroll
                for (int j = 0; j < 4; ++j) { ssy += y[r][i][j] * y[r][i][j]; ss2 += y2[r][i][j] * y2[r][i][j]; } }
            rsy[r] = rsqrtf(wave_sum(ssy) * (1.f / 1024.f) + 1e-6f); rs2[r] = rsqrtf(wave_sum(ss2) * (1.f / 1024.f) + 1e-6f); }
#pragma unroll
        for (int i = 0; i < 4; ++i) { const int c = i * 256 + lane * 4;
            const f32x4 np0 = *(const f32x4*)(p.in[7] + c), np1 = *(const f32x4*)(p.in[7] + 1024 + c), g0 = *(const f32x4*)(gt0 + c), g1 = *(const f32x4*)(gt1 + c);
#pragma unroll
            for (int r = 0; r < 2; ++r) { f32x4 o;
#pragma unroll
                for (int j = 0; j < 4; ++j) { const float x1 = v[r][i][j] + g0[j] * (y[r][i][j] * rsy[r] * np0[j]); o[j] = x1 + g1[j] * (y2[r][i][j] * rs2[r] * np1[j]); }
                ntstore(o, (f32x4*)(p.out + (size_t)(row + r) * D + c)); } }
    }
}


#define XB_TMO      128
#define XB_XCNT(j)  (256  + 64 * (j))
#define XB_XSUB(j)  (1280 + 64 * (j))
#define XB_XGEN(j)  (2304 + 64 * (j))
#define XB_TOP      3328
#define XB_TOPGEN   3392
#define XCD_BAR_WORDS 3456
#define XB_SPIN_CAP (1u << 18)
DI unsigned xb_ld(unsigned* p)              { return __hip_atomic_load(p, __ATOMIC_RELAXED, __HIP_MEMORY_SCOPE_AGENT); }
DI unsigned xb_add(unsigned* p, unsigned v) { return __hip_atomic_fetch_add(p, v, __ATOMIC_RELAXED, __HIP_MEMORY_SCOPE_AGENT); }
DI unsigned xb_xcc_id() { return (unsigned)__builtin_amdgcn_s_getreg((3 << 11) | 20) & 0xFu; }
#define XB_SPIN(cond, bar) do { unsigned _sp = 0; while (cond) { __builtin_amdgcn_s_sleep(1); \
    if ((++_sp & 255u) == 0u) { if (xb_ld(&(bar)[XB_TMO])) break; if (_sp > XB_SPIN_CAP) { atomicAdd(&(bar)[XB_TMO], 1u); break; } } } } while (0)
struct XcdBarrier { unsigned* bar; unsigned x; volatile LAS unsigned* st; };
DI XcdBarrier xcd_barrier_post(unsigned* bar, volatile LAS unsigned* st) {
    XcdBarrier b; b.bar = bar; b.x = xb_xcc_id(); b.st = st;
    if (threadIdx.x == 0) (void)xb_add(&bar[XB_XCNT(b.x)], 1u);
    return b;
}
DI void xcd_barrier_complete(unsigned* bar, unsigned x, unsigned& nloc, unsigned& nx) {
    const unsigned G = gridDim.x * gridDim.y * gridDim.z;
    unsigned sum, cnt, mine, sp = 0u;
    for (;;) {
        sum = 0u; cnt = 0u; mine = 0u;
#pragma unroll
        for (unsigned j = 0; j < 16; ++j) { const unsigned c = xb_ld(&bar[XB_XCNT(j)]); sum += c; cnt += (c > 0u) ? 1u : 0u; mine = (j == x) ? c : mine; }
        if (sum == G) break;
        __builtin_amdgcn_s_sleep(1);
        if ((++sp & 255u) == 0u) { if (xb_ld(&bar[XB_TMO])) break; if (sp > XB_SPIN_CAP) { atomicAdd(&bar[XB_TMO], 1u); break; } }
    }
    nloc = mine > 0u ? mine : 1u; nx = cnt > 0u ? cnt : 1u;
}
DI void xcd_barrier(const XcdBarrier& b) {
    asm volatile("s_waitcnt vmcnt(0)" ::: "memory");
    __syncthreads();
    if (threadIdx.x == 0) {
        unsigned* bar = b.bar;
        __builtin_amdgcn_s_waitcnt(0);
        unsigned nloc = b.st[0], nx = b.st[1];
        if (nloc == 0u) { xcd_barrier_complete(bar, b.x, nloc, nx); b.st[0] = nloc; b.st[1] = nx; }
        const unsigned old = xb_add(&bar[XB_XSUB(b.x)], 1u);
        const unsigned gen = old / nloc;
        if (old + 1u == (gen + 1u) * nloc) {
            __builtin_amdgcn_fence(__ATOMIC_RELEASE, "agent");
            asm volatile("s_waitcnt vmcnt(0)" ::: "memory");
            const unsigned og = xb_add(&bar[XB_TOP], 1u);
            const unsigned tg = og / nx;
            if (og + 1u == (tg + 1u) * nx) xb_add(&bar[XB_TOPGEN], 1u);
            else XB_SPIN(xb_ld(&bar[XB_TOPGEN]) == tg, bar);
            __builtin_amdgcn_fence(__ATOMIC_ACQUIRE, "agent");
            xb_add(&bar[XB_XGEN(b.x)], 1u);
            asm volatile("s_waitcnt vmcnt(0)" ::: "memory");
        } else {
            XB_SPIN(xb_ld(&bar[XB_XGEN(b.x)]) == gen, bar);
            __builtin_amdgcn_fence(__ATOMIC_ACQUIRE, "agent");
            asm volatile("s_waitcnt vmcnt(0)" ::: "memory");
        }
    }
    __syncthreads();
}

constexpr int NPHASE = 18;
__global__ void __launch_bounds__(512, 2) fwd_megakernel(Params p, int ph0, int ph1) {
    extern __shared__ __attribute__((aligned(16))) unsigned char shm[];
    __shared__ __attribute__((aligned(16))) unsigned xb_words[4];
    LAS unsigned char* lds = (LAS unsigned char*)shm;
    cg::grid_group grid = cg::this_grid();
    XcdBarrier xb; xb.bar = (unsigned*)(p.ws + OFF_BAR); xb.x = 0; xb.st = (volatile LAS unsigned*)xb_words;
    if (ph1 - ph0 > 1) { if (threadIdx.x < 4) xb_words[threadIdx.x] = 0u; __syncthreads(); xb = xcd_barrier_post((unsigned*)(p.ws + OFF_BAR), (volatile LAS unsigned*)xb_words); }
    pg8::StaticOrder S;
#define PHASE(k) if (((PH_MASK >> (k)) & 1) && ph0 <= (k) && (k) < ph1)
#define SYNC(k) if (ph0 <= (k) && (k) + 1 < ph1) { if (ph1 > NPHASE) grid.sync(); else xcd_barrier(xb); }
    PHASE(0) { phase_prep(p, shm); } SYNC(0);
    PHASE(1) {
        if (blockIdx.x < 64 && gridDim.x > 64) phase_transposes(p, shm, blockIdx.x, 64);
        else if (gridDim.x > 64) phase_h0(p, blockIdx.x - 64, gridDim.x - 64);
        else { phase_transposes(p, shm, blockIdx.x, gridDim.x); phase_h0(p, blockIdx.x, gridDim.x); }
    } SYNC(1);
    PHASE(2) {
        pg8::Gemm g = {(const u16*)(p.ws + OFF_R0), (const u16*)(p.ws + OFF_WT1), M, 3328, 1024, 1024, 1024, 0, 0};
        EpiBf16Split E; E.base[0] = (u16*)(p.ws + OFF_R1); E.base[1] = (u16*)(p.ws + OFF_R2); E.base[2] = (u16*)(p.ws + OFF_R3); E.split_tiles = 4; E.ldc = 1024; E.lr = (float*)(p.ws + OFF_LR); E.lr_tile = 12;
        S.init(g.M, g.N, gridDim.x, blockIdx.x); pg8::gemm_phase(lds, g, S, E);
    } SYNC(2);
    PHASE(3) { phase_gla_chunk(p, shm, p.out); } SYNC(3);
    PHASE(4) { phase_gla_seq<0>(p, shm, p.out); } SYNC(4);
    PHASE(5) { phase_gla_combine(p, MX, M, blockIdx.x, gridDim.x); } SYNC(5);
    PHASE(6) {
        if (blockIdx.x < 16) {
            pg8::Gemm g = {(const u16*)(p.ws + OFF_R4) + (size_t)MX * 1024, (const u16*)(p.ws + OFF_WT2), MC, 1024, 1024, 1024, 1024, 0, 0};
            EpiBf16Split E; E.base[0] = E.base[1] = E.base[2] = (u16*)(p.ws + OFF_Y); E.split_tiles = 64; E.ldc = 1024; E.lr = nullptr; E.lr_tile = -1; E.row_base = MX;
            S.init(g.M, g.N, 16, blockIdx.x); pg8::gemm_phase(lds, g, S, E);
        } else phase_gla_combine(p, 0, MX, blockIdx.x - 16, gridDim.x - 16);
    } SYNC(6);
    PHASE(7) {
        pg8::Gemm g = {(const u16*)(p.ws + OFF_R4), (const u16*)(p.ws + OFF_WT2), MX, 1024, 1024, 1024, 1024, 0, 0};
        EpiBf16Split E; E.base[0] = E.base[1] = E.base[2] = (u16*)(p.ws + OFF_Y); E.split_tiles = 64; E.ldc = 1024; E.lr = nullptr; E.lr_tile = -1;
        S.init(g.M, g.N, gridDim.x, blockIdx.x); pg8::gemm_phase(lds, g, S, E);
    } SYNC(7);
    PHASE(8) { phase_h1(p, MX, M, blockIdx.x, gridDim.x); } SYNC(8);
    PHASE(9) {
        if (blockIdx.x < 40) {
            pg8::Gemm g = {(const u16*)(p.ws + OFF_R0) + (size_t)MX * 1024, (const u16*)(p.ws + OFF_WT3), MC, 2560, 1024, 1024, 1024, 0, 0};
            EpiBf16Split E; E.base[0] = (u16*)(p.ws + OFF_Z); E.base[1] = E.base[2] = (u16*)(p.ws + OFF_G2); E.split_tiles = 5; E.ldc = 1280; E.lr = nullptr; E.lr_tile = -1; E.row_base = MX;
            S.init(g.M, g.N, 40, blockIdx.x); pg8::gemm_phase(lds, g, S, E);
        } else phase_h1(p, 0, MX, blockIdx.x - 40, gridDim.x - 40);
    } SYNC(9);
    PHASE(10) {
        pg8::Gemm g = {(const u16*)(p.ws + OFF_R0), (const u16*)(p.ws + OFF_WT3), MX, 2560, 1024, 1024, 1024, 0, 0};
        EpiBf16Split E; E.base[0] = (u16*)(p.ws + OFF_Z); E.base[1] = E.base[2] = (u16*)(p.ws + OFF_G2); E.split_tiles = 5; E.ldc = 1280; E.lr = nullptr; E.lr_tile = -1;
        S.init(g.M, g.N, gridDim.x, blockIdx.x); pg8::gemm_phase(lds, g, S, E);
    } SYNC(10);
    PHASE(11) { phase_conv(p, p.out); } SYNC(11);
    PHASE(12) {
        pg8::Gemm g = {(const u16*)p.out, (const u16*)(p.ws + OFF_WT4), M, 5120, 256, 1280, 256, 2, 512};
        EpiPair E; E.GA = (unsigned*)(p.ws + OFF_AU);
        S.init(g.M, g.N, gridDim.x, blockIdx.x); pg8::gemm_phase(lds, g, S, E);
    } SYNC(12);
    PHASE(13) { phase_lru_agg(p, p.out); } SYNC(13);
    PHASE(14) { phase_lru_carry(p); } SYNC(14);
    PHASE(15) { phase_lru_apply(p, shm, p.out); } SYNC(15);
    PHASE(16) {
        pg8::Gemm g = {(const u16*)p.out, (const u16*)(p.ws + OFF_WT5), MX, 1024, 1280, 1280, 1280, 0, 0};
        EpiBf16Split E; E.base[0] = E.base[1] = E.base[2] = (u16*)(p.ws + OFF_Y2); E.split_tiles = 64; E.ldc = 1024; E.lr = nullptr; E.lr_tile = -1;
        S.init(g.M, g.N, gridDim.x, blockIdx.x); pg8::gemm_phase(lds, g, S, E);
    } SYNC(16);
    PHASE(17) { phase_final(p); }
#undef PHASE
#undef SYNC
}

extern "C" void kernel_launch(void* const* d_in, const int* in_sizes, int n_in, void* d_out, int out_size, void* d_ws, size_t ws_size, hipStream_t stream) {
    constexpr size_t kDynLds = 131072;
    static int grid_blocks = 0;
    if (!grid_blocks) {
        hipFuncSetAttribute((const void*)fwd_megakernel, hipFuncAttributeMaxDynamicSharedMemorySize, (int)kDynLds);
        int dev = 0, cus = 0, per_cu = 0;
        hipGetDevice(&dev);
        hipDeviceGetAttribute(&cus, hipDeviceAttributeMultiprocessorCount, dev);
        hipOccupancyMaxActiveBlocksPerMultiprocessor(&per_cu, fwd_megakernel, 512, kDynLds);
        if (per_cu < 1) per_cu = 1;
        grid_blocks = cus * 1;
    }
    Params p{};
    for (int i = 0; i < 29; ++i) p.in[i] = (const float*)d_in[i];
    p.out = (float*)d_out; p.ws = (unsigned char*)d_ws;
#if MULTI_LAUNCH
    for (int k = 0; k < NPHASE; ++k) for (int rep = 0; rep <= ((REP_MASK >> k) & 1); ++rep) fwd_megakernel<<<dim3(grid_blocks), dim3(512), kDynLds, stream>>>(p, k, k + 1);
#else
    int ph0 = 0, ph1 = NPHASE;
    (void)hipMemsetAsync((unsigned char*)d_ws + OFF_BAR, 0, XCD_BAR_WORDS * sizeof(unsigned), stream);
    void* args[] = {&p, &ph0, &ph1};
    hipError_t e = hipLaunchCooperativeKernel((void*)fwd_megakernel, dim3(grid_blocks), dim3(512), args, kDynLds, stream);
    if (e != hipSuccess) fprintf(stderr, "cooperative launch failed: %s (grid %d)\n", hipGetErrorString(e), grid_blocks);
#endif
}
```

```cpp
#include <hip/hip_runtime.h>
#include <hip/hip_cooperative_groups.h>
#include <cstdio>
namespace cg = cooperative_groups;

#ifndef PH_MASK
#define PH_MASK 0xFFFFFF
#endif
#ifndef REP_MASK
#define REP_MASK 0
#endif
#ifndef EXTRA
#define EXTRA 0
#endif
#ifndef MULTI_LAUNCH
#define MULTI_LAUNCH 0
#endif

typedef unsigned short u16;
typedef short bf16x8 __attribute__((ext_vector_type(8)));
typedef float f32x4 __attribute__((ext_vector_type(4)));
typedef float f32x2 __attribute__((ext_vector_type(2)));
typedef unsigned u32x4 __attribute__((ext_vector_type(4)));
typedef unsigned u32x2 __attribute__((ext_vector_type(2)));
typedef __bf16 bfv2 __attribute__((ext_vector_type(2)));
#define LAS __attribute__((address_space(3)))
#define DI __device__ __forceinline__

constexpr int D = 1024, MX = 32768, MC = 1024, M = MX + MC;
constexpr int NCH = M / 64;
constexpr int LW = 1280;
constexpr size_t MiB = 1024 * 1024;
constexpr size_t OFF_Y = 0;
constexpr size_t OFF_R0 = 66 * MiB;
constexpr size_t OFF_R1 = 132 * MiB;
constexpr size_t OFF_R2 = 198 * MiB;
constexpr size_t OFF_R3 = 264 * MiB;
constexpr size_t OFF_R4 = 330 * MiB;
constexpr size_t OFF_VT = 396 * MiB;
constexpr size_t OFF_WT1 = 462 * MiB;
constexpr size_t OFF_WT2 = OFF_WT1 + 7 * MiB;
constexpr size_t OFF_LR = OFF_WT2 + 2 * MiB;
constexpr size_t OFF_EL = OFF_LR + 5 * MiB;
constexpr size_t OFF_MOD = 479 * MiB;
constexpr size_t OFF_WT3 = OFF_MOD + 1 * MiB;
constexpr size_t OFF_WT4 = OFF_WT3 + 5 * MiB;
constexpr size_t OFF_WT5 = OFF_WT4 + 3 * MiB;
constexpr size_t OFF_CA = OFF_WT5 + 3 * MiB;
constexpr size_t OFF_CU = OFF_CA + 6 * MiB;
constexpr size_t OFF_HS = OFF_CU + 6 * MiB;
constexpr size_t OFF_BAR = OFF_HS + 6 * MiB;
constexpr size_t OFF_AU = 66 * MiB;
constexpr size_t OFF_Z = 132 * MiB;
constexpr size_t OFF_G2 = 396 * MiB;
constexpr size_t OFF_Y2 = 66 * MiB;

struct Params {
    const float* in[29];
    float* out;
    unsigned char* ws;
};

template <class T> DI T ntload(const T* p) { return __builtin_nontemporal_load(p); }
template <class T> DI void ntstore(T v, T* p) { __builtin_nontemporal_store(v, p); }
DI float bf2f(u16 b) { return __uint_as_float(((unsigned)b) << 16); }
DI unsigned pk2(float lo, float hi) { f32x2 v = {lo, hi}; bfv2 b = __builtin_convertvector(v, bfv2); return __builtin_bit_cast(unsigned, b); }
DI u16 f2bf(float f) { return (u16)(pk2(f, 0.f) & 0xffffu); }
DI float lo_bf(unsigned w) { return __uint_as_float(w << 16); }
DI float hi_bf(unsigned w) { return __uint_as_float(w & 0xffff0000u); }
DI float wave_sum(float v) {
#pragma unroll
    for (int o = 32; o; o >>= 1) v += __shfl_xor(v, o);
    return v;
}
DI float fexp(float x) { return __builtin_amdgcn_exp2f(x * 1.4426950408889634f); }
DI float flog(float x) { return __builtin_amdgcn_logf(x) * 0.6931471805599453f; }
DI float sigmoid_f(float x) { return __builtin_amdgcn_rcpf(1.f + fexp(-x)); }
DI float silu_f(float x) { return x * sigmoid_f(x); }

namespace pg8 {
constexpr int BM = 256, BK = 64, HALF = 128, HTB = HALF * BK * 2, STAGE_BYTES = 8 * HTB, NXCD = 8, WGM = 8;
DI int lds_byte(int r, int c) { const int st = (r >> 4) * 2 + (c >> 5), rr = r & 15, cc = c & 31, ob = rr * 64 + cc * 2; return st * 1024 + (ob ^ (((ob >> 9) & 1) << 5)); }
DI void stage_rc(int b, int& R, int& C) { const int st = b / 1024, sb = b % 1024, swz = sb ^ (((sb >> 9) & 1) << 5); R = (st >> 1) * 16 + swz / 64; C = (st & 1) * 32 + (swz % 64) / 2; }
DI int perm32(int rho) { const int n = rho >> 4, i = rho & 15; return 8 * (i >> 2) + 4 * n + (i & 3); }
struct Unit { int pm, pn; };
struct Gemm { const u16* A; const u16* Bt; int M, N, K, lda, ldb, a_shift, a_colbytes; };
struct StaticOrder {
    int nM, nN, nwg, G, c;
    DI void init(int M_, int N_, int G_, int c_) { nM = M_ / BM; nN = N_ / BM; nwg = nM * nN; G = G_; c = c_; }
    DI bool next(int i, Unit& u) const {
        const long L = (long)i * G + c; if (L >= nwg) return false;
        int wgid = (int)L; { const int q = nwg / NXCD, r = nwg % NXCD, xcd = wgid % NXCD, off = wgid / NXCD; wgid = (xcd < r ? xcd * (q + 1) : r * (q + 1) + (xcd - r) * q) + off; }
        const int nig = WGM * nN, gid = wgid / nig, fm = gid * WGM, gsz = (nM - fm) < WGM ? (nM - fm) : WGM;
        u.pm = fm + ((wgid % nig) % gsz); u.pn = (wgid % nig) / gsz; return true;
    }
};

template <class Epi>
DI void gemm_phase(LAS unsigned char* lds, const Gemm g, const StaticOrder& S, const Epi& E) {
    const int tid = threadIdx.x, wid = __builtin_amdgcn_readfirstlane(tid >> 6), lane = tid & 63, wr = wid >> 2, wc = wid & 3, fr = lane & 15, fq = lane >> 4;
    const int K = g.K, nt = K / BK;
    unsigned voffA[2], voffB[2];
#pragma unroll
    for (int i = 0; i < 2; ++i) { int R, C; stage_rc(tid * 16 + i * 8192, R, C); const int Rb = Epi::PERM ? ((R & ~31) + perm32(R & 31)) : R;
        voffA[i] = (unsigned)(R * g.lda + C) * 2u; voffB[i] = (unsigned)(Rb * g.ldb + C) * 2u; }
    const size_t kstep = (size_t)(BK * 2);
    const size_t hstepA = (size_t)HALF * g.lda * 2, hstepB = (size_t)HALF * g.ldb * 2;
    const unsigned ldsw = (unsigned)wid * 1024u;
    const int aoff = lds_byte(wr * 64 + fr, fq * 8), boff = lds_byte(wc * 32 + fr, fq * 8);
#define PG8_SA(b, h) (((b) * 2 + (h)) * HTB)
#define PG8_SB(b, h) ((4 + (b) * 2 + (h)) * HTB)
#define PG8_STAGE(bufoff, gbase, voff) do { _Pragma("unroll") for (int _i = 0; _i < 2; ++_i) \
        __builtin_amdgcn_global_load_lds((const unsigned*)((const char*)(gbase) + (voff)[_i]), (LAS unsigned*)(lds + (bufoff) + ldsw + _i * 8192), 16, 0, 0); } while (0)
#define PG8_LDA(dst, b, h) do { _Pragma("unroll") for (int m = 0; m < 4; ++m) _Pragma("unroll") for (int k = 0; k < 2; ++k) dst[m][k] = *(const LAS bf16x8*)(lds + PG8_SA(b, h) + aoff + m * 2048 + k * 1024); } while (0)
#define PG8_LDB(dst, b, h) do { _Pragma("unroll") for (int n = 0; n < 2; ++n) _Pragma("unroll") for (int k = 0; k < 2; ++k) dst[n][k] = *(const LAS bf16x8*)(lds + PG8_SB(b, h) + boff + n * 2048 + k * 1024); } while (0)
#define PG8_MMA(ai, bj, At, Bt) do { __builtin_amdgcn_s_setprio(1); _Pragma("unroll") for (int m = 0; m < 4; ++m) _Pragma("unroll") for (int n = 0; n < 2; ++n) _Pragma("unroll") for (int k = 0; k < 2; ++k) \
        acc[ai][bj][m][n] = __builtin_amdgcn_mfma_f32_16x16x32_bf16(Bt[n][k], At[m][k], acc[ai][bj][m][n], 0, 0, 0); __builtin_amdgcn_s_setprio(0); } while (0)
#define PG8_WAIT_V(n) asm volatile("s_waitcnt vmcnt(" #n ")" ::: "memory")
#define PG8_WAIT_L(n) asm volatile("s_waitcnt lgkmcnt(" #n ")" ::: "memory")
#define PG8_BAR __builtin_amdgcn_s_barrier()
#define PG8_SCHED __builtin_amdgcn_sched_barrier(0)
#define PG8_APTR(u) ((const char*)g.A + (size_t)(u).pm * 2 * hstepA + (size_t)((u).pn >> g.a_shift) * g.a_colbytes)
#define PG8_BPTR(u) ((const char*)g.Bt + (size_t)(u).pn * 2 * hstepB)
    Unit cur, nxt; int ui = 0;
    if (!S.next(0, cur)) return;
    f32x4 acc[2][2][4][2];
#pragma unroll
    for (int a = 0; a < 2; ++a)
#pragma unroll
        for (int b = 0; b < 2; ++b)
#pragma unroll
            for (int m = 0; m < 4; ++m)
#pragma unroll
                for (int n = 0; n < 2; ++n) acc[a][b][m][n] = (f32x4){0.f, 0.f, 0.f, 0.f};
    bf16x8 At[4][2], B0[2][2], B1[2][2];
    const char* cA = PG8_APTR(cur); const char* cB = PG8_BPTR(cur);
    PG8_STAGE(PG8_SB(0, 0), cB, voffB); PG8_STAGE(PG8_SA(0, 0), cA, voffA); PG8_STAGE(PG8_SB(0, 1), cB + hstepB, voffB); PG8_STAGE(PG8_SA(0, 1), cA + hstepA, voffA);
    if (wr == 1) PG8_BAR;
    PG8_WAIT_V(4); PG8_BAR;
    PG8_STAGE(PG8_SB(1, 0), cB + kstep, voffB); PG8_STAGE(PG8_SA(1, 0), cA + kstep, voffA); PG8_STAGE(PG8_SB(1, 1), cB + hstepB + kstep, voffB);
    PG8_WAIT_V(6); PG8_BAR;
    for (;;) {
        const bool has_next = S.next(ui + 1, nxt);
        const char* nA = has_next ? PG8_APTR(nxt) : cA; const char* nB = has_next ? PG8_BPTR(nxt) : cB;
        for (int t = 0; t < nt; t += 2) {
            const bool last = (t == nt - 2);
            const char* a1 = cA + (size_t)(t + 1) * kstep;
            const char* a2 = last ? nA : cA + (size_t)(t + 2) * kstep; const char* b2 = last ? nB : cB + (size_t)(t + 2) * kstep;
            const char* a3 = a2 + kstep; const char* b3 = b2 + kstep;
            PG8_LDB(B0, 0, 0); PG8_SCHED; PG8_LDA(At, 0, 0); PG8_STAGE(PG8_SA(1, 1), a1 + hstepA, voffA);
            PG8_WAIT_L(8); PG8_BAR; PG8_WAIT_L(0); PG8_MMA(0, 0, At, B0); PG8_BAR; PG8_SCHED;
            PG8_LDB(B1, 0, 1); PG8_STAGE(PG8_SB(0, 0), b2, voffB);
            PG8_BAR; PG8_WAIT_L(0); PG8_MMA(0, 1, At, B1); PG8_BAR;
            PG8_LDA(At, 0, 1); PG8_STAGE(PG8_SA(0, 0), a2, voffA);
            PG8_BAR; PG8_WAIT_L(0); PG8_MMA(1, 0, At, B0); PG8_BAR; PG8_SCHED;
            PG8_STAGE(PG8_SB(0, 1), b2 + hstepB, voffB);
            PG8_WAIT_V(6); PG8_BAR; PG8_MMA(1, 1, At, B1); PG8_BAR;
            PG8_LDB(B0, 1, 0); PG8_SCHED; PG8_LDA(At, 1, 0); PG8_STAGE(PG8_SA(0, 1), a2 + hstepA, voffA);
            PG8_WAIT_L(8); PG8_BAR; PG8_WAIT_L(0); PG8_MMA(0, 0, At, B0); PG8_BAR; PG8_SCHED;
            PG8_LDB(B1, 1, 1); PG8_STAGE(PG8_SB(1, 0), b3, voffB);
            PG8_BAR; PG8_WAIT_L(0); PG8_MMA(0, 1, At, B1); PG8_BAR;
            PG8_LDA(At, 1, 1); PG8_STAGE(PG8_SA(1, 0), a3, voffA);
            PG8_BAR; PG8_WAIT_L(0); PG8_MMA(1, 0, At, B0); PG8_BAR; PG8_SCHED;
            PG8_STAGE(PG8_SB(1, 1), b3 + hstepB, voffB);
            PG8_WAIT_V(6); PG8_BAR; PG8_MMA(1, 1, At, B1); PG8_BAR;
        }
        E(acc, cur, wr, wc, fr, fq);
        if (!has_next) break;
#pragma unroll
        for (int a = 0; a < 2; ++a)
#pragma unroll
            for (int b = 0; b < 2; ++b)
#pragma unroll
                for (int m = 0; m < 4; ++m)
#pragma unroll
                    for (int n = 0; n < 2; ++n) acc[a][b][m][n] = (f32x4){0.f, 0.f, 0.f, 0.f};
        cur = nxt; cA = nA; cB = nB; ++ui;
    }
    PG8_WAIT_V(0);
    if (wr == 0) PG8_BAR;
    PG8_BAR;
#undef PG8_SA
#undef PG8_SB
#undef PG8_STAGE
#undef PG8_LDA
#undef PG8_LDB
#undef PG8_MMA
#undef PG8_WAIT_V
#undef PG8_WAIT_L
#undef PG8_BAR
#undef PG8_SCHED
#undef PG8_APTR
#undef PG8_BPTR
}
}
using pg8::Unit;

struct EpiBf16Split {
    static constexpr bool PERM = true;
    u16* base[3]; int split_tiles; int ldc; float* lr; int lr_tile;
    int row_base = 0;
    DI void operator()(const f32x4 (&acc)[2][2][4][2], const Unit& u, int wr, int wc, int fr, int fq) const {
        const int row0 = row_base + u.pm * 256 + wr * 64 + fr;
        if (u.pn == lr_tile) {
            if (wc == 0) {
#pragma unroll
                for (int ai = 0; ai < 2; ++ai)
#pragma unroll
                    for (int m = 0; m < 4; ++m) { float* rp = lr + (size_t)(row0 + ai * 128 + m * 16) * 32 + 8 * fq;
                        *(f32x4*)(rp) = acc[ai][0][m][0]; *(f32x4*)(rp + 4) = acc[ai][0][m][1]; }
            }
            return;
        }
        const int t = u.pn / split_tiles; u16* b = t == 0 ? base[0] : (t == 1 ? base[1] : base[2]);
        const int col0 = (u.pn - t * split_tiles) * 256 + wc * 32 + 8 * fq;
#pragma unroll
        for (int ai = 0; ai < 2; ++ai)
#pragma unroll
            for (int m = 0; m < 4; ++m) { u16* rowp = b + (size_t)(row0 + ai * 128 + m * 16) * ldc + col0;
#pragma unroll
                for (int bj = 0; bj < 2; ++bj) { const f32x4 v0 = acc[ai][bj][m][0], v1 = acc[ai][bj][m][1];
                    u32x4 w; w.x = pk2(v0[0], v0[1]); w.y = pk2(v0[2], v0[3]); w.z = pk2(v1[0], v1[1]); w.w = pk2(v1[2], v1[3]);
                    *(u32x4*)(rowp + bj * 128) = w; } }
    }
};
struct EpiPair {
    static constexpr bool PERM = true;
    unsigned* GA;
    DI void operator()(const f32x4 (&acc)[2][2][4][2], const Unit& u, int wr, int wc, int fr, int fq) const {
        const int blk = u.pn >> 2, dir = (u.pn >> 1) & 1, half = u.pn & 1;
        const int row0 = u.pm * 256 + wr * 64 + fr;
        unsigned* ga = GA + (size_t)dir * M * LW + blk * 256 + half * 128 + wc * 32 + 8 * fq;
#pragma unroll
        for (int ai = 0; ai < 2; ++ai)
#pragma unroll
            for (int m = 0; m < 4; ++m) { unsigned* rp = ga + (size_t)(row0 + ai * 128 + m * 16) * LW;
#pragma unroll
                for (int n = 0; n < 2; ++n) { u32x4 w;
#pragma unroll
                    for (int j = 0; j < 4; ++j) w[j] = pk2(acc[ai][0][m][n][j], acc[ai][1][m][n][j]);
                    *(u32x4*)(rp + 4 * n) = w; } }
    }
};
DI void gate_au(unsigned w, float z, float ba, float bx, float c8, float& a, float& u) {
    const float r = sigmoid_f(lo_bf(w) + ba), ig = sigmoid_f(hi_bf(w) + bx);
    a = fexp(-c8 * r); u = __builtin_amdgcn_sqrtf(fmaxf(1.f - a * a, 0.f)) * ig * z;
}

DI void phase_prep(const Params& p, unsigned char* shm) {
    const int tid = threadIdx.x;
    float* scS = (float*)shm;
    float* red = scS + 5 * 1024;
    float* MOD = (float*)(p.ws + OFF_MOD);
    for (int i = tid; i < 5 * 1024; i += 512) { const int v = i >> 10, k = i & 1023; const float cv = v < 4 ? p.in[1][v * 1024 + k] : p.in[3][k]; scS[i] = silu_f(cv); }
    __syncthreads();
    for (int item = blockIdx.x; item < 192; item += gridDim.x) {
        const int layer = item / 96, n0 = (item % 96) * 32, col = tid & 31, kg = tid >> 5;
        float a0 = 0.f, a1 = 0.f, a2 = 0.f, a3 = 0.f, a4 = 0.f;
        const float* w = p.in[4] + (size_t)layer * 1024 * 3072 + n0 + col;
#pragma unroll 16
        for (int kk = 0; kk < 64; ++kk) { const int k = kg * 64 + kk; const float wv = w[(size_t)k * 3072];
            a0 += scS[k] * wv; a1 += scS[1024 + k] * wv; a2 += scS[2048 + k] * wv; a3 += scS[3072 + k] * wv; a4 += scS[4096 + k] * wv; }
        red[(kg * 5 + 0) * 32 + col] = a0; red[(kg * 5 + 1) * 32 + col] = a1; red[(kg * 5 + 2) * 32 + col] = a2; red[(kg * 5 + 3) * 32 + col] = a3; red[(kg * 5 + 4) * 32 + col] = a4;
        __syncthreads();
        if (tid < 160) { const int v = tid >> 5, c2 = tid & 31; float s = 0.f;
#pragma unroll
            for (int q = 0; q < 16; ++q) s += red[(q * 5 + v) * 32 + c2];
            MOD[(layer * 5 + v) * 3072 + n0 + c2] = s + p.in[5][layer * 3072 + n0 + c2]; }
        __syncthreads();
    }
}
DI void phase_transposes(const Params& p, unsigned char* shm, int wgi, int nwg) {
    const int tid = threadIdx.x;
    float* tile = (float*)shm;
    constexpr int T0 = 16 * 49, T1 = T0 + 256, T2 = T1 + 640, T3 = T2 + 320, T4 = T3 + 320;
    for (int tb = wgi; tb < T4; tb += 4 * nwg) {
        const float* src[4]; u16* dst[4]; int sld[4], dld[4], Nn[4], k0[4], n0[4]; bool valid[4];
#pragma unroll
        for (int u = 0; u < 4; ++u) {
            const int tl = tb + u * nwg; valid[u] = tl < T4; const int tc = valid[u] ? tl : 0; int kt, ntl;
            if (tc < T0) { kt = tc / 49; ntl = tc % 49; src[u] = p.in[8]; sld[u] = 3104; Nn[u] = 3104; dst[u] = (u16*)(p.ws + OFF_WT1); dld[u] = 1024; }
            else if (tc < T1) { const int t = tc - T0; kt = t / 16; ntl = t % 16; src[u] = p.in[14]; sld[u] = 1024; Nn[u] = 1024; dst[u] = (u16*)(p.ws + OFF_WT2); dld[u] = 1024; }
            else if (tc < T2) { const int t = tc - T1; kt = t / 40; ntl = t % 40; src[u] = p.in[15]; sld[u] = 2560; Nn[u] = 2560; dst[u] = (u16*)(p.ws + OFF_WT3); dld[u] = 1024; }
            else if (tc < T3) { const int t = tc - T2; kt = t / 16; ntl = t % 16; src[u] = p.in[28]; sld[u] = 1024; Nn[u] = 1024; dst[u] = (u16*)(p.ws + OFF_WT5); dld[u] = 1280; }
            else { const int t = tc - T3; const int j = t >> 3, tt = t & 7; kt = tt >> 1; ntl = tt & 1;
                const int gate = j / 10, rem = j % 10, blk = rem >> 1, half = rem & 1, dir = gate >> 1, isx = gate & 1;
                const float* gp = gate == 0 ? p.in[18] : (gate == 1 ? p.in[20] : (gate == 2 ? p.in[23] : p.in[25]));
                src[u] = gp + blk * 65536 + half * 128; sld[u] = 256; Nn[u] = 128;
                dst[u] = (u16*)(p.ws + OFF_WT4) + (size_t)((blk * 4 + dir * 2 + half) * 256 + isx * 128) * 256; dld[u] = 256; }
            k0[u] = kt * 64; n0[u] = ntl * 64;
        }
        float v[4][8];
#pragma unroll
        for (int u = 0; u < 4; ++u)
#pragma unroll
            for (int i = 0; i < 8; ++i) { const int e = tid + i * 512, kr = e >> 6, nc = e & 63;
                v[u][i] = (n0[u] + nc < Nn[u]) ? src[u][(size_t)(k0[u] + kr) * sld[u] + n0[u] + nc] : 0.f; }
        __syncthreads();
#pragma unroll
        for (int u = 0; u < 4; ++u)
#pragma unroll
            for (int i = 0; i < 8; ++i) { const int e = tid + i * 512, kr = e >> 6, nc = e & 63; tile[u * 4160 + kr * 65 + nc] = v[u][i]; }
        __syncthreads();
#pragma unroll
        for (int u = 0; u < 4; ++u) if (valid[u]) {
#pragma unroll
            for (int i = 0; i < 4; ++i) { const int pi = tid + i * 512, nr = pi >> 5, kc = (pi & 31) * 2;
                if (n0[u] + nr < Nn[u]) *(unsigned*)(dst[u] + (size_t)(n0[u] + nr) * dld[u] + k0[u] + kc) = pk2(tile[u * 4160 + kc * 65 + nr], tile[u * 4160 + (kc + 1) * 65 + nr]); } }
    }
}

DI const float* row_src(const Params& p, int row) { return row < MX ? p.in[0] + (size_t)row * D : p.in[2] + (size_t)(row - MX) * D; }
DI int row_perm(int row) { if (row >= MX) return row; const int b = row >> 13, t = row & 8191; return (b << 13) + (t & 63) * 128 + (t >> 6); }

DI void phase_h0(const Params& p, int wgi, int nwg) {
    const int wave = threadIdx.x >> 6, lane = threadIdx.x & 63;
    const float* MOD = (const float*)(p.ws + OFF_MOD);
    u16* H = (u16*)(p.ws + OFF_R0);
    for (int row = wgi * 16 + wave * 2; row < M; row += nwg * 16) {
        const int vec = row < MX ? row >> 13 : 4;
        const float* mod = MOD + (size_t)vec * 3072;
        f32x4 v[2][4]; float ss[2] = {0.f, 0.f};
#pragma unroll
        for (int r = 0; r < 2; ++r) { const float* src = row_src(p, row + r);
#pragma unroll
            for (int i = 0; i < 4; ++i) v[r][i] = ntload((const f32x4*)(src + i * 256 + lane * 4)); }
#pragma unroll
        for (int r = 0; r < 2; ++r) {
#pragma unroll
            for (int i = 0; i < 4; ++i) ss[r] += v[r][i][0] * v[r][i][0] + v[r][i][1] * v[r][i][1] + v[r][i][2] * v[r][i][2] + v[r][i][3] * v[r][i][3];
            ss[r] = rsqrtf(wave_sum(ss[r]) * (1.f / 1024.f) + 1e-6f); }
#pragma unroll
        for (int i = 0; i < 4; ++i) { const int c = i * 256 + lane * 4;
            const f32x4 g = *(const f32x4*)(p.in[6] + c), sh = *(const f32x4*)(mod + c), sc = *(const f32x4*)(mod + 1024 + c);
#pragma unroll
            for (int r = 0; r < 2; ++r) { float o[4];
#pragma unroll
                for (int j = 0; j < 4; ++j) o[j] = v[r][i][j] * ss[r] * g[j] * (1.f + sc[j]) + sh[j];
                u32x2 w; w.x = pk2(o[0], o[1]); w.y = pk2(o[2], o[3]); *(u32x2*)(H + (size_t)(row + r) * D + c) = w; } }
    }
}

DI void phase_gla_chunk(const Params& p, unsigned char* shm, float* outbuf) {
    const int tid = threadIdx.x, wave = tid >> 6, lane = tid & 63, l15 = lane & 15, lg4 = lane >> 4;
    float* lrS = (float*)shm;
    float* wgS = lrS + 64 * 32;
    float* bgS = wgS + 2 * 16 * 128;
    float* totS = bgS + 256;
    u16* qtS = (u16*)(totS + 512);
    u16* kbS = qtS + 64 * 136;
    u16* PS = kbS + 64 * 136;
    u16* vTS = PS + 64 * 72;
    u16* ktS = vTS + 256 * 72;
    const float* LR = (const float*)(p.ws + OFF_LR);
    const u16* QK = (const u16*)(p.ws + OFF_R1);
    const u16* V = (const u16*)(p.ws + OFF_R2);
    u16* QX = (u16*)(p.ws + OFF_R4);
    u16* KT = (u16*)outbuf;
    u16* VT = (u16*)(p.ws + OFF_VT);
    float* EL = (float*)(p.ws + OFF_EL);
    u16* OINTRA = (u16*)(p.ws + OFF_R0);
    int h_loaded = -1;
    for (int item = blockIdx.x; item < NCH * 4; item += gridDim.x) {
        const int cidx = item >> 2, h = item & 3, row0 = cidx * 64;
        u16 qraw[16], kraw[16], vraw[32]; float lrv[4];
        { const u16* qp = QK + (size_t)(row0 + (tid >> 7) * 16) * D + h * 128 + (tid & 127);
#pragma unroll
          for (int tt = 0; tt < 16; ++tt) { qraw[tt] = ntload(qp + (size_t)tt * D); kraw[tt] = ntload(qp + (size_t)tt * D + 512); }
          const u16* vp = V + (size_t)(row0 + (tid >> 8) * 32) * D + h * 256 + (tid & 255);
#pragma unroll
          for (int t2 = 0; t2 < 32; ++t2) vraw[t2] = ntload(vp + (size_t)t2 * D);
#pragma unroll
          for (int i = 0; i < 4; ++i) lrv[i] = LR[(size_t)row0 * 32 + tid + i * 512]; }
        if (h != h_loaded) {
            float wv[8]; float bv = 0.f;
#pragma unroll
            for (int i = 0; i < 8; ++i) { const int e = tid + i * 512, d = e >> 11, r = (e >> 7) & 15, k = e & 127; wv[i] = (d ? p.in[11] : p.in[9])[r * 512 + h * 128 + k]; }
            if (tid < 256) { const int d = tid >> 7, k = tid & 127; bv = (d ? p.in[12] : p.in[10])[h * 128 + k]; }
#pragma unroll
            for (int i = 0; i < 8; ++i) wgS[tid + i * 512] = wv[i];
            if (tid < 256) bgS[tid] = bv;
            h_loaded = h;
        }
#pragma unroll
        for (int i = 0; i < 4; ++i) lrS[tid + i * 512] = lrv[i];
        {
            const int v = tid & 255, th = tid >> 8;
            unsigned pw[16];
#pragma unroll
            for (int t2 = 0; t2 < 16; ++t2) pw[t2] = (unsigned)vraw[2 * t2] | ((unsigned)vraw[2 * t2 + 1] << 16);
#pragma unroll
            for (int q = 0; q < 4; ++q) { const u32x4 w = {pw[4 * q], pw[4 * q + 1], pw[4 * q + 2], pw[4 * q + 3]};
                *(u32x4*)(vTS + v * 72 + th * 32 + q * 8) = w; }
        }
        __syncthreads();
        {
            u16* g = VT + (size_t)(cidx * 4 + h) * 16384;
#pragma unroll
            for (int j = 0; j < 4; ++j) { const int id = tid + j * 512; *(u32x4*)(g + id * 8) = *(const u32x4*)(vTS + (id >> 3) * 72 + (id & 7) * 8); }
        }
        f32x4 pacc[2] = {{0.f, 0.f, 0.f, 0.f}, {0.f, 0.f, 0.f, 0.f}};
#pragma unroll
        for (int dir = 0; dir < 2; ++dir) {
            const int k = tid & 127, tg = tid >> 7;
            float wreg[16];
#pragma unroll
            for (int r = 0; r < 16; ++r) wreg[r] = wgS[(dir * 16 + r) * 128 + k];
            const float bgv = bgS[dir * 128 + k];
            float lg[16];
#pragma unroll
            for (int tt = 0; tt < 16; ++tt) { const int t = tg * 16 + tt; float z = bgv;
#pragma unroll
                for (int r = 0; r < 16; ++r) z += lrS[t * 32 + dir * 16 + r] * wreg[r];
                lg[tt] = -(fmaxf(-z, 0.f) + flog(1.f + fexp(-fabsf(z)))) * (1.f / 16.f); }
            float run = 0.f;
            if (dir == 0) {
#pragma unroll
                for (int tt = 0; tt < 16; ++tt) { run += lg[tt]; lg[tt] = run; }
            } else {
#pragma unroll
                for (int tt = 15; tt >= 0; --tt) { run += lg[tt]; lg[tt] = run; }
            }
            totS[tg * 128 + k] = run;
            __syncthreads();
            float off = 0.f, total = 0.f;
#pragma unroll
            for (int g2 = 0; g2 < 4; ++g2) { const float tv = totS[g2 * 128 + k]; total += tv; if (dir == 0 ? (g2 < tg) : (g2 > tg)) off += tv; }
            unsigned kh[8];
            u16* qx = QX + (size_t)dir * M * 512;
#pragma unroll
            for (int t2 = 0; t2 < 8; ++t2) {
                float khv[2];
#pragma unroll
                for (int e = 0; e < 2; ++e) { const int tt = 2 * t2 + e, t = tg * 16 + tt;
                    const float cum = lg[tt] + off;
                    const float qv = bf2f(qraw[tt]) * 0.08838834764831845f;
                    const float kv = bf2f(kraw[tt]);
                    const u16 qt = f2bf(qv * fexp(cum));
                    qtS[t * 136 + k] = qt;
                    kbS[t * 136 + k] = f2bf(kv * fexp(-cum));
                    khv[e] = kv * fexp(total - cum); }
                kh[t2] = pk2(khv[0], khv[1]);
            }
            { const u32x4 w0 = {kh[0], kh[1], kh[2], kh[3]}, w1 = {kh[4], kh[5], kh[6], kh[7]};
              *(u32x4*)(ktS + k * 72 + tg * 16) = w0; *(u32x4*)(ktS + k * 72 + tg * 16 + 8) = w1; }
            if (tg == 0) EL[((size_t)dir * NCH + cidx) * 512 + h * 128 + k] = fexp(total);
            __syncthreads();
            {
#pragma unroll
                for (int j = 0; j < 2; ++j) { const int id = tid + j * 512;
                    { const int t_ = id >> 4, pc = id & 15, ks_ = pc >> 2, d_ = pc & 3;
                      const u32x2 lo = *(const u32x2*)(qtS + t_ * 136 + ks_ * 32 + 4 * d_), hi = *(const u32x2*)(qtS + t_ * 136 + ks_ * 32 + 16 + 4 * d_);
                      const u32x4 w = {lo.x, lo.y, hi.x, hi.y};
                      *(u32x4*)(qx + (size_t)(row0 + t_) * 512 + h * 128 + pc * 8) = w; }
                    *(u32x4*)(KT + (((size_t)dir * NCH + cidx) * 4 + h) * 8192 + id * 8) = *(const u32x4*)(ktS + (id >> 3) * 72 + (id & 7) * 8); }
            }
#pragma unroll
            for (int x = 0; x < 2; ++x) { const int id = wave * 2 + x, it = id >> 2, jt = id & 3;
                if (dir == 0 ? (jt <= it) : (jt >= it)) {
                    f32x4 a4 = {0.f, 0.f, 0.f, 0.f};
#pragma unroll
                    for (int ks = 0; ks < 4; ++ks) { const bf16x8 a = *(const bf16x8*)(qtS + (it * 16 + l15) * 136 + ks * 32 + lg4 * 8);
                        const bf16x8 b = *(const bf16x8*)(kbS + (jt * 16 + l15) * 136 + ks * 32 + lg4 * 8);
                        a4 = __builtin_amdgcn_mfma_f32_16x16x32_bf16(a, b, a4, 0, 0, 0); }
#pragma unroll
                    for (int r = 0; r < 4; ++r) { const int i = it * 16 + lg4 * 4 + r, j = jt * 16 + l15;
                        const bool keep = dir == 0 ? (j <= i) : (j >= i); pacc[x][r] += keep ? a4[r] : 0.f; }
                }
            }
            __syncthreads();
        }
#pragma unroll
        for (int x = 0; x < 2; ++x) { const int id = wave * 2 + x, it = id >> 2, jt = id & 3;
#pragma unroll
            for (int r = 0; r < 4; ++r) PS[(it * 16 + lg4 * 4 + r) * 72 + jt * 16 + l15] = f2bf(pacc[x][r]); }
        __syncthreads();
#pragma unroll
        for (int x = 0; x < 2; ++x) { const int vt = wave * 2 + x;
            const bf16x8 av0 = *(const bf16x8*)(vTS + (vt * 16 + l15) * 72 + lg4 * 8), av1 = *(const bf16x8*)(vTS + (vt * 16 + l15) * 72 + 32 + lg4 * 8);
#pragma unroll
            for (int it = 0; it < 4; ++it) {
                const bf16x8 b0 = *(const bf16x8*)(PS + (it * 16 + l15) * 72 + lg4 * 8), b1 = *(const bf16x8*)(PS + (it * 16 + l15) * 72 + 32 + lg4 * 8);
                f32x4 a4 = {0.f, 0.f, 0.f, 0.f};
                a4 = __builtin_amdgcn_mfma_f32_16x16x32_bf16(av0, b0, a4, 0, 0, 0);
                a4 = __builtin_amdgcn_mfma_f32_16x16x32_bf16(av1, b1, a4, 0, 0, 0);
                u32x2 w; w.x = pk2(a4[0], a4[1]); w.y = pk2(a4[2], a4[3]);
                *(u32x2*)(OINTRA + (size_t)(row0 + it * 16 + l15) * D + h * 256 + vt * 16 + lg4 * 4) = w; }
        }
        __syncthreads();
    }
}

template <int MODE> DI void phase_gla_seq(const Params& p, unsigned char* shm, const float* outbuf) {
    const int tid = threadIdx.x, wave = __builtin_amdgcn_readfirstlane(tid >> 6), lane = tid & 63, l15 = lane & 15, lg4 = lane >> 4;
    constexpr int QS_B = 64 * 288, KS_B = 128 * 144, VS_B = 32 * 144, BUF_B = QS_B + KS_B + VS_B + 512;
    constexpr int SF_OFF = 2 * BUF_B, SF_B = 8192;
    const u16* VT = (const u16*)(p.ws + OFF_VT);
    const float* ELb = (const float*)(p.ws + OFF_EL);
#define SEQ_BAR() do { __builtin_amdgcn_fence(__ATOMIC_RELEASE, "workgroup"); __builtin_amdgcn_s_barrier(); __builtin_amdgcn_fence(__ATOMIC_ACQUIRE, "workgroup"); } while (0)
    for (int item0 = blockIdx.x; item0 < 256; item0 += gridDim.x) {
        const int item = (((item0 & 7) * 4 + (item0 >> 6)) << 3) | ((item0 >> 3) & 7);
        const int vs = item & 7, dir = (item >> 3) & 1, h = (item >> 4) & 3, b = item >> 6;
        const unsigned char* QX = (const unsigned char*)((const u16*)(p.ws + OFF_R4) + (size_t)dir * M * 512 + h * 128);
        const unsigned char* KT = (const unsigned char*)((const u16*)outbuf + (size_t)dir * NCH * 4 * 8192 + (size_t)h * 8192);
        const unsigned char* VTb = (const unsigned char*)(VT + (size_t)h * 16384 + vs * 32 * 64);
        const unsigned char* EL = (const unsigned char*)(ELb + (size_t)dir * NCH * 512 + h * 128);
        u16* OI = (u16*)(p.ws + (dir ? OFF_R2 : OFF_R1));
#define SEQ_CIDX(s) ((s) < 4 ? 512 + 4 * b + (dir ? 3 - (s) : (s)) : 128 * b + (dir ? 127 - ((s) - 4) : ((s) - 4)))
        __syncthreads();
        *(u32x4*)(shm + SF_OFF + tid * 16) = (u32x4){0u, 0u, 0u, 0u};
        if (wave >= 4) {
            const int lt = tid - 256;
            unsigned soff[10], doff[10]; int kind[10];
#pragma unroll
            for (int i = 0; i < 10; ++i) { int id = lt + i * 256; if (id > 2335) id = 2335;
                if (id < 1024) { kind[i] = 0; soff[i] = (unsigned)((id >> 4) * 1024 + (id & 15) * 16); doff[i] = (unsigned)((id >> 4) * 288 + (id & 15) * 16); }
                else if (id < 2048) { const int j = id - 1024; kind[i] = 1; soff[i] = (unsigned)(j * 16); doff[i] = (unsigned)(QS_B + (j >> 3) * 144 + (j & 7) * 16); }
                else if (id < 2304) { const int j = id - 2048; kind[i] = 2; soff[i] = (unsigned)(j * 16); doff[i] = (unsigned)(QS_B + KS_B + (j >> 3) * 144 + (j & 7) * 16); }
                else { const int j = id - 2304; kind[i] = 3; soff[i] = (unsigned)(j * 16); doff[i] = (unsigned)(QS_B + KS_B + VS_B + j * 16); } }
            const bool last_valid = (lt + 9 * 256) < 2336;
            u32x4 ra[10], rb[10], rc[10], rd[10];
#define SEQ_LOAD(R, s) do { const int sl_ = (s) < 132 ? (s) : 131; const int ci = SEQ_CIDX(sl_); \
                const unsigned char* b0 = QX + (size_t)ci * 65536; const unsigned char* b1 = KT + (size_t)ci * 65536; \
                const unsigned char* b2 = VTb + (size_t)ci * 131072; const unsigned char* b3 = EL + (size_t)ci * 2048; \
                _Pragma("unroll") for (int i = 0; i < 10; ++i) { const unsigned char* bp = kind[i] == 0 ? b0 : (kind[i] == 1 ? b1 : (kind[i] == 2 ? b2 : b3)); R[i] = *(const u32x4*)(bp + soff[i]); } } while (0)
#define SEQ_STORE(R, bi) do { unsigned char* bb = shm + (bi) * BUF_B; \
                _Pragma("unroll") for (int i = 0; i < 9; ++i) *(u32x4*)(bb + doff[i]) = R[i]; \
                *(u32x4*)(last_valid ? bb + doff[9] : shm + SF_OFF + 2 * SF_B + lt * 16) = R[9]; } while (0)
#define SEQ_STEP(R, s) do { if ((s) + 1 < 132) SEQ_STORE(R, ((s) + 1) & 1); SEQ_LOAD(R, (s) + 5); SEQ_BAR(); } while (0)
            SEQ_LOAD(ra, 0); SEQ_STORE(ra, 0);
            SEQ_LOAD(ra, 1); SEQ_LOAD(rb, 2); SEQ_LOAD(rc, 3); SEQ_LOAD(rd, 4);
            SEQ_BAR();
            for (int s = 0; s < 132; s += 4) { SEQ_STEP(ra, s); SEQ_STEP(rb, s + 1); SEQ_STEP(rc, s + 2); SEQ_STEP(rd, s + 3); }
#undef SEQ_LOAD
#undef SEQ_STORE
#undef SEQ_STEP
        } else if (wave < 2) {
            f32x4 S[8];
#pragma unroll
            for (int i = 0; i < 8; ++i) S[i] = (f32x4){0.f, 0.f, 0.f, 0.f};
            SEQ_BAR();
            for (int s = 0; s < 132; ++s) {
                const unsigned char* bb = shm + (s & 1) * BUF_B;
                bf16x8 ka[8][2], vb[2]; f32x4 el[8];
#pragma unroll
                for (int ts = 0; ts < 2; ++ts) { vb[ts] = *(const bf16x8*)(bb + QS_B + KS_B + (wave * 16 + l15) * 144 + ts * 64 + lg4 * 16);
#pragma unroll
                    for (int kt = 0; kt < 8; ++kt) ka[kt][ts] = *(const bf16x8*)(bb + QS_B + (kt * 16 + l15) * 144 + ts * 64 + lg4 * 16); }
#pragma unroll
                for (int kt = 0; kt < 8; ++kt) el[kt] = *(const f32x4*)(bb + QS_B + KS_B + VS_B + (kt * 16 + lg4 * 4) * 4);
#pragma unroll
                for (int kt = 0; kt < 8; ++kt) S[kt] = S[kt] * el[kt];
#pragma unroll
                for (int ts = 0; ts < 2; ++ts)
#pragma unroll
                    for (int kt = 0; kt < 8; ++kt) S[kt] = __builtin_amdgcn_mfma_f32_16x16x32_bf16(ka[kt][ts], vb[ts], S[kt], 0, 0, 0);
                unsigned char* sfp = shm + SF_OFF + ((s + 1) & 1) * SF_B + wave * 4096 + lane * 16;
#pragma unroll
                for (int ks = 0; ks < 4; ++ks) { u32x4 w; w.x = pk2(S[2 * ks][0], S[2 * ks][1]); w.y = pk2(S[2 * ks][2], S[2 * ks][3]);
                    w.z = pk2(S[2 * ks + 1][0], S[2 * ks + 1][1]); w.w = pk2(S[2 * ks + 1][2], S[2 * ks + 1][3]); *(u32x4*)(sfp + ks * 1024) = w; }
                SEQ_BAR();
            }
        } else {
            const int w2 = wave - 2;
            SEQ_BAR();
            for (int s = 0; s < 132; ++s) {
                const unsigned char* bb = shm + (s & 1) * BUF_B;
                const int cidx = SEQ_CIDX(s);
                const unsigned char* sfp = shm + SF_OFF + (s & 1) * SF_B + w2 * 4096 + lane * 16;
                bf16x8 sf[4]; u32x4 qf[4][4];
#pragma unroll
                for (int ks = 0; ks < 4; ++ks) sf[ks] = *(const bf16x8*)(sfp + ks * 1024);
#pragma unroll
                for (int tt = 0; tt < 4; ++tt)
#pragma unroll
                    for (int ks = 0; ks < 4; ++ks) qf[tt][ks] = *(const u32x4*)(bb + (tt * 16 + l15) * 288 + ks * 64 + lg4 * 16);
                f32x4 a4[4];
#pragma unroll
                for (int tt = 0; tt < 4; ++tt) a4[tt] = (f32x4){0.f, 0.f, 0.f, 0.f};
#pragma unroll
                for (int ks = 0; ks < 4; ++ks)
#pragma unroll
                    for (int tt = 0; tt < 4; ++tt) a4[tt] = __builtin_amdgcn_mfma_f32_16x16x32_bf16(sf[ks], __builtin_bit_cast(bf16x8, qf[tt][ks]), a4[tt], 0, 0, 0);
#pragma unroll
                for (int tt = 0; tt < 4; ++tt) { u32x2 w; w.x = pk2(a4[tt][0], a4[tt][1]); w.y = pk2(a4[tt][2], a4[tt][3]);
                    *(u32x2*)(OI + (size_t)(cidx * 64 + tt * 16 + l15) * D + h * 256 + vs * 32 + w2 * 16 + lg4 * 4) = w; }
                SEQ_BAR();
            }
        }
#undef SEQ_CIDX
    }
#undef SEQ_BAR
}

DI void phase_gla_combine(const Params& p, int row_lo, int row_hi, int wgi, int nwg) {
    const int wave = threadIdx.x >> 6, lane = threadIdx.x & 63;
    const u16* O0 = (const u16*)(p.ws + OFF_R0); const u16* O1 = (const u16*)(p.ws + OFF_R1); const u16* O2 = (const u16*)(p.ws + OFF_R2);
    const u16* G = (const u16*)(p.ws + OFF_R3); u16* A2 = (u16*)(p.ws + OFF_R4);
    const int vc = (lane & 31) * 8;
    const f32x4 gn0 = *(const f32x4*)(p.in[13] + vc), gn1 = *(const f32x4*)(p.in[13] + vc + 4);
    const float gn[8] = {gn0[0], gn0[1], gn0[2], gn0[3], gn1[0], gn1[1], gn1[2], gn1[3]};
    for (int row = row_lo + wgi * 16 + wave * 2; row < row_hi; row += nwg * 16) {
        u32x4 a[2][2], b[2][2], c[2][2], g[2][2];
#pragma unroll
        for (int r = 0; r < 2; ++r)
#pragma unroll
            for (int q = 0; q < 2; ++q) { const size_t o = (size_t)(row + r) * D + q * 512 + lane * 8;
                a[r][q] = ntload((const u32x4*)(O0 + o)); b[r][q] = ntload((const u32x4*)(O1 + o)); c[r][q] = ntload((const u32x4*)(O2 + o)); g[r][q] = ntload((const u32x4*)(G + o)); }
#pragma unroll
        for (int r = 0; r < 2; ++r)
#pragma unroll
            for (int q = 0; q < 2; ++q) {
                float v[8]; float ss = 0.f;
#pragma unroll
                for (int j = 0; j < 4; ++j) { v[2 * j] = lo_bf(a[r][q][j]) + lo_bf(b[r][q][j]) + lo_bf(c[r][q][j]); v[2 * j + 1] = hi_bf(a[r][q][j]) + hi_bf(b[r][q][j]) + hi_bf(c[r][q][j]); }
#pragma unroll
                for (int j = 0; j < 8; ++j) ss += v[j] * v[j];
                ss += __shfl_xor(ss, 1); ss += __shfl_xor(ss, 2); ss += __shfl_xor(ss, 4); ss += __shfl_xor(ss, 8); ss += __shfl_xor(ss, 16);
                const float rstd = rsqrtf(ss * (1.f / 256.f) + 1e-6f);
                u32x4 w;
#pragma unroll
                for (int j = 0; j < 4; ++j) { const float g0 = lo_bf(g[r][q][j]), g1 = hi_bf(g[r][q][j]);
                    w[j] = pk2(v[2 * j] * rstd * gn[2 * j] * silu_f(g0), v[2 * j + 1] * rstd * gn[2 * j + 1] * silu_f(g1)); }
                *(u32x4*)(A2 + (size_t)(row + r) * D + q * 512 + lane * 8) = w;
            }
    }
}

DI void phase_h1(const Params& p, int row_lo, int row_hi, int wgi, int nwg) {
    const int wave = threadIdx.x >> 6, lane = threadIdx.x & 63;
    const float* MOD = (const float*)(p.ws + OFF_MOD);
    const u16* Y = (const u16*)(p.ws + OFF_Y);
    u16* H = (u16*)(p.ws + OFF_R0);
    for (int row = row_lo + wgi * 16 + wave * 2; row < row_hi; row += nwg * 16) {
        const int vec = row < MX ? row >> 13 : 4;
        const float* mod0 = MOD + (size_t)vec * 3072; const float* mod1 = MOD + (size_t)(5 + vec) * 3072;
        f32x4 v[2][4]; u32x2 yy[2][4];
#pragma unroll
        for (int r = 0; r < 2; ++r) { const float* src = row_src(p, row + r);
#pragma unroll
            for (int i = 0; i < 4; ++i) { const int c = i * 256 + lane * 4; v[r][i] = ntload((const f32x4*)(src + c)); yy[r][i] = *(const u32x2*)(Y + (size_t)(row + r) * D + c); } }
        float rsy[2], rstd[2];
        f32x4 y[2][4];
#pragma unroll
        for (int r = 0; r < 2; ++r) { float ssy = 0.f;
#pragma unroll
            for (int i = 0; i < 4; ++i) { y[r][i] = (f32x4){lo_bf(yy[r][i].x), hi_bf(yy[r][i].x), lo_bf(yy[r][i].y), hi_bf(yy[r][i].y)};
                ssy += y[r][i][0] * y[r][i][0] + y[r][i][1] * y[r][i][1] + y[r][i][2] * y[r][i][2] + y[r][i][3] * y[r][i][3]; }
            rsy[r] = rsqrtf(wave_sum(ssy) * (1.f / 1024.f) + 1e-6f); }
        float ss[2] = {0.f, 0.f};
#pragma unroll
        for (int i = 0; i < 4; ++i) { const int c = i * 256 + lane * 4;
            const f32x4 np = *(const f32x4*)(p.in[7] + c), gt = *(const f32x4*)(mod0 + 2048 + c);
#pragma unroll
            for (int r = 0; r < 2; ++r)
#pragma unroll
                for (int j = 0; j < 4; ++j) { v[r][i][j] += gt[j] * (y[r][i][j] * rsy[r] * np[j]); ss[r] += v[r][i][j] * v[r][i][j]; } }
#pragma unroll
        for (int r = 0; r < 2; ++r) rstd[r] = rsqrtf(wave_sum(ss[r]) * (1.f / 1024.f) + 1e-6f);
#pragma unroll
        for (int i = 0; i < 4; ++i) { const int c = i * 256 + lane * 4;
            const f32x4 g = *(const f32x4*)(p.in[6] + 1024 + c), sh = *(const f32x4*)(mod1 + c), sc = *(const f32x4*)(mod1 + 1024 + c);
#pragma unroll
            for (int r = 0; r < 2; ++r) { float o[4];
#pragma unroll
                for (int j = 0; j < 4; ++j) o[j] = v[r][i][j] * rstd[r] * g[j] * (1.f + sc[j]) + sh[j];
                u32x2 w; w.x = pk2(o[0], o[1]); w.y = pk2(o[2], o[3]); *(u32x2*)(H + (size_t)row_perm(row + r) * D + c) = w; } }
    }
}

DI void phase_conv(const Params& p, float* outbuf) {
    const u16* Z = (const u16*)(p.ws + OFF_Z); u16* ZC = (u16*)outbuf;
    const float* cw = p.in[16]; const float* cb = p.in[17];
    const int total = (M / 8) * 160;
    for (int idx = blockIdx.x * 512 + threadIdx.x; idx < total; idx += gridDim.x * 512) {
        const int row0 = (idx / 160) * 8, ch = (idx % 160) * 8;
        const int pos0 = row0 < MX ? (row0 & 8191) : ((row0 - MX) & 255), len = row0 < MX ? 8192 : 256;
        u32x4 z[11];
#pragma unroll
        for (int i = 0; i < 11; ++i) { const int pp = pos0 + i - 2;
            z[i] = (pp >= 0 && pp < len) ? ntload((const u32x4*)(Z + (size_t)(row0 + i - 2) * LW + ch)) : (u32x4){0u, 0u, 0u, 0u}; }
        f32x4 w[4][2], bias[2];
#pragma unroll
        for (int j = 0; j < 4; ++j) { w[j][0] = *(const f32x4*)(cw + j * LW + ch); w[j][1] = *(const f32x4*)(cw + j * LW + ch + 4); }
        bias[0] = *(const f32x4*)(cb + ch); bias[1] = *(const f32x4*)(cb + ch + 4);
#pragma unroll
        for (int r = 0; r < 8; ++r) {
            f32x4 a0 = bias[0], a1 = bias[1];
#pragma unroll
            for (int j = 0; j < 4; ++j) { const u32x4 zz = z[r + j];
                a0[0] += w[j][0][0] * lo_bf(zz.x); a0[1] += w[j][0][1] * hi_bf(zz.x); a0[2] += w[j][0][2] * lo_bf(zz.y); a0[3] += w[j][0][3] * hi_bf(zz.y);
                a1[0] += w[j][1][0] * lo_bf(zz.z); a1[1] += w[j][1][1] * hi_bf(zz.z); a1[2] += w[j][1][2] * lo_bf(zz.w); a1[3] += w[j][1][3] * hi_bf(zz.w); }
            const u32x4 o = {pk2(a0[0], a0[1]), pk2(a0[2], a0[3]), pk2(a1[0], a1[1]), pk2(a1[2], a1[3])};
            *(u32x4*)(ZC + (size_t)(row0 + r) * LW + ch) = o;
        }
    }
}

DI void phase_lru_agg(const Params& p, const float* outbuf) {
    const unsigned* GAf = (const unsigned*)(p.ws + OFF_AU); const unsigned* GAb = GAf + (size_t)M * LW;
    const u16* ZC = (const u16*)outbuf;
    float* CA = (float*)(p.ws + OFF_CA); float* CU = (float*)(p.ws + OFF_CU);
    const int total = NCH * 320 * 2;
    for (int idx = blockIdx.x * 512 + threadIdx.x; idx < total; idx += gridDim.x * 512) {
        const int half = idx & 1, i2 = idx >> 1, c4 = i2 % 320, cidx = i2 / 320, ch = c4 * 4;
        const f32x4 baf = *(const f32x4*)(p.in[19] + ch), bxf = *(const f32x4*)(p.in[21] + ch), lf = *(const f32x4*)(p.in[22] + ch);
        const f32x4 bab = *(const f32x4*)(p.in[24] + ch), bxb = *(const f32x4*)(p.in[26] + ch), lb = *(const f32x4*)(p.in[27] + ch);
        f32x4 c8f, c8b;
#pragma unroll
        for (int j = 0; j < 4; ++j) { c8f[j] = 8.f * flog(1.f + fexp(-lf[j])); c8b[j] = 8.f * flog(1.f + fexp(-lb[j])); }
        const unsigned base = ((unsigned)cidx * 64u + half * 32u) * LW + ch;
        f32x4 Af = {1.f, 1.f, 1.f, 1.f}, Uf = {0.f, 0.f, 0.f, 0.f}, Pb = {1.f, 1.f, 1.f, 1.f}, Ub = {0.f, 0.f, 0.f, 0.f};
        u32x4 gfA[4], gbA[4], gfB[4], gbB[4]; u32x2 zcA[4], zcB[4];
#define AGG_LOAD(GF, GB, ZZ, tb) do { _Pragma("unroll") for (int q = 0; q < 4; ++q) { const unsigned o = base + (unsigned)((tb) * 4 + q) * LW; GF[q] = ntload((const u32x4*)(GAf + o)); GB[q] = ntload((const u32x4*)(GAb + o)); ZZ[q] = *(const u32x2*)(ZC + o); } } while (0)
#define AGG_COMP(GF, GB, ZZ) do { _Pragma("unroll") for (int q = 0; q < 4; ++q) { \
                const float z[4] = {lo_bf(ZZ[q].x), hi_bf(ZZ[q].x), lo_bf(ZZ[q].y), hi_bf(ZZ[q].y)}; \
                _Pragma("unroll") for (int j = 0; j < 4; ++j) { float a, u; \
                    gate_au(GF[q][j], z[j], baf[j], bxf[j], c8f[j], a, u); Uf[j] = a * Uf[j] + u; Af[j] *= a; \
                    gate_au(GB[q][j], z[j], bab[j], bxb[j], c8b[j], a, u); Ub[j] += Pb[j] * u; Pb[j] *= a; } } } while (0)
        AGG_LOAD(gfA, gbA, zcA, 0);
        for (int tb = 0; tb < 8; tb += 2) {
            AGG_LOAD(gfB, gbB, zcB, tb + 1);
            AGG_COMP(gfA, gbA, zcA);
            if (tb + 2 < 8) AGG_LOAD(gfA, gbA, zcA, tb + 2);
            AGG_COMP(gfB, gbB, zcB);
        }
#undef AGG_LOAD
#undef AGG_COMP
        f32x4 Af1, Uf1, Pb1, Ub1;
#pragma unroll
        for (int j = 0; j < 4; ++j) { Af1[j] = __shfl_xor(Af[j], 1); Uf1[j] = __shfl_xor(Uf[j], 1); Pb1[j] = __shfl_xor(Pb[j], 1); Ub1[j] = __shfl_xor(Ub[j], 1); }
        if (half == 0) {
            f32x4 A, U, P, UB;
#pragma unroll
            for (int j = 0; j < 4; ++j) { A[j] = Af[j] * Af1[j]; U[j] = Af1[j] * Uf[j] + Uf1[j]; P[j] = Pb[j] * Pb1[j]; UB[j] = Ub[j] + Pb[j] * Ub1[j]; }
            const size_t o = (size_t)cidx * LW + ch;
            *(f32x4*)(CA + o) = A; *(f32x4*)(CU + o) = U; *(f32x4*)(CA + (size_t)NCH * LW + o) = P; *(f32x4*)(CU + (size_t)NCH * LW + o) = UB;
        }
    }
}
DI void phase_lru_carry(const Params& p) {
    const float* CA = (const float*)(p.ws + OFF_CA); const float* CU = (const float*)(p.ws + OFF_CU); float* HS = (float*)(p.ws + OFF_HS);
    for (int idx = blockIdx.x * 512 + threadIdx.x; idx < 4 * 2 * LW; idx += gridDim.x * 512) {
        const int ch = idx % LW, dir = (idx / LW) & 1, b = idx / (2 * LW);
        float h = 0.f;
        for (int s0 = 0; s0 < 132; s0 += 12) {
            size_t o[12]; float a[12], u[12];
#pragma unroll
            for (int q = 0; q < 12; ++q) { const int s = s0 + q; const int cidx = s < 4 ? 512 + 4 * b + (dir ? 3 - s : s) : 128 * b + (dir ? 127 - (s - 4) : (s - 4));
                o[q] = ((size_t)dir * NCH + cidx) * LW + ch; a[q] = CA[o[q]]; u[q] = CU[o[q]]; }
#pragma unroll
            for (int q = 0; q < 12; ++q) { HS[o[q]] = h; h = a[q] * h + u[q]; }
        }
    }
}
DI void phase_lru_apply(const Params& p, unsigned char* shm, float* outbuf) {
    const int tid = threadIdx.x;
    float* hf = (float*)shm;
    const unsigned* GAf = (const unsigned*)(p.ws + OFF_AU); const unsigned* GAb = GAf + (size_t)M * LW;
    const float* HS = (const float*)(p.ws + OFF_HS);
    const u16* G2 = (const u16*)(p.ws + OFF_G2); u16* ZA = (u16*)outbuf;
    for (int wi = blockIdx.x; wi < 1280; wi += gridDim.x) {
        const int item = wi * 2 + (tid >> 8), cidx = item / 5, ch = (item % 5) * 256 + (tid & 255);
        const unsigned base = (unsigned)cidx * 64u * LW + ch;
        const float baf = p.in[19][ch], bxf = p.in[21][ch], c8f = 8.f * flog(1.f + fexp(-p.in[22][ch]));
        const float bab = p.in[24][ch], bxb = p.in[26][ch], c8b = 8.f * flog(1.f + fexp(-p.in[27][ch]));
        float h = HS[(size_t)cidx * LW + ch];
        const float hb0 = HS[((size_t)NCH + cidx) * LW + ch];
        for (int tb = 0; tb < 2; ++tb) {
            unsigned w[32]; u16 z[32];
#pragma unroll
            for (int q = 0; q < 32; ++q) { const unsigned o = base + (unsigned)(tb * 32 + q) * LW; w[q] = ntload(GAf + o); z[q] = ZA[o]; }
#pragma unroll
            for (int q = 0; q < 32; ++q) { float a, u; gate_au(w[q], bf2f(z[q]), baf, bxf, c8f, a, u); h = a * h + u; hf[(tb * 32 + q) * 512 + tid] = h; }
        }
        h = hb0;
        for (int tb = 3; tb >= 0; --tb) {
            unsigned w[16]; u16 z[16], g[16];
#pragma unroll
            for (int q = 0; q < 16; ++q) { const unsigned o = base + (unsigned)(tb * 16 + q) * LW; w[q] = ntload(GAb + o); z[q] = ntload(ZA + o); g[q] = ntload(G2 + o); }
#pragma unroll
            for (int q = 15; q >= 0; --q) { float a, u; gate_au(w[q], bf2f(z[q]), bab, bxb, c8b, a, u); h = a * h + u;
                const float tot = hf[(tb * 16 + q) * 512 + tid] + h;
                ZA[base + (unsigned)(tb * 16 + q) * LW] = f2bf(tot * silu_f(bf2f(g[q]))); }
        }
    }
}

DI void phase_final(const Params& p) {
    const int wave = threadIdx.x >> 6, lane = threadIdx.x & 63;
    const float* MOD = (const float*)(p.ws + OFF_MOD);
    const u16* Y = (const u16*)(p.ws + OFF_Y); const u16* Y2 = (const u16*)(p.ws + OFF_Y2);
    for (int row = blockIdx.x * 16 + wave * 2; row < MX; row += gridDim.x * 16) {
        const int vec = row >> 13;
        const float* gt0 = MOD + (size_t)vec * 3072 + 2048; const float* gt1 = MOD + (size_t)(5 + vec) * 3072 + 2048;
        f32x4 v[2][4]; u32x2 yy[2][4], zz[2][4];
#pragma unroll
        for (int r = 0; r < 2; ++r) { const float* src = p.in[0] + (size_t)(row + r) * D; const size_t prow = (size_t)row_perm(row + r);
#pragma unroll
            for (int i = 0; i < 4; ++i) { const int c = i * 256 + lane * 4; v[r][i] = ntload((const f32x4*)(src + c));
                yy[r][i] = ntload((const u32x2*)(Y + (size_t)(row + r) * D + c)); zz[r][i] = ntload((const u32x2*)(Y2 + prow * D + c)); } }
        f32x4 y[2][4], y2[2][4]; float rsy[2], rs2[2];
#pragma unroll
        for (int r = 0; r < 2; ++r) { float ssy = 0.f, ss2 = 0.f;
#pragma unroll
            for (int i = 0; i < 4; ++i) { y[r][i] = (f32x4){lo_bf(yy[r][i].x), hi_bf(yy[r][i].x), lo_bf(yy[r][i].y), hi_bf(yy[r][i].y)};
                y2[r][i] = (f32x4){lo_bf(zz[r][i].x), hi_bf(zz[r][i].x), lo_bf(zz[r][i].y), hi_bf(zz[r][i].y)};
#pragma unroll
                for (int j = 0; j < 4; ++j) { ssy += y[r][i][j] * y[r][i][j]; ss2 += y2[r][i][j] * y2[r][i][j]; } }
            rsy[r] = rsqrtf(wave_sum(ssy) * (1.f / 1024.f) + 1e-6f); rs2[r] = rsqrtf(wave_sum(ss2) * (1.f / 1024.f) + 1e-6f); }
#pragma unroll
        for (int i = 0; i < 4; ++i) { const int c = i * 256 + lane * 4;
            const f32x4 np0 = *(const f32x4*)(p.in[7] + c), np1 = *(const f32x4*)(p.in[7] + 1024 + c), g0 = *(const f32x4*)(gt0 + c), g1 = *(const f32x4*)(gt1 + c);
#pragma unroll
            for (int r = 0; r < 2; ++r) { f32x4 o;
#pragma unroll
                for (int j = 0; j < 4; ++j) { const float x1 = v[r][i][j] + g0[j] * (y[r][i][j] * rsy[r] * np0[j]); o[j] = x1 + g1[j] * (y2[r][i][j] * rs2[r] * np1[j]); }
                ntstore(o, (f32x4*)(p.out + (size_t)(row + r) * D + c)); } }
    }
}


#define XB_TMO      128
#define XB_XCNT(j)  (256  + 64 * (j))
#define XB_XSUB(j)  (1280 + 64 * (j))
#define XB_XGEN(j)  (2304 + 64 * (j))
#define XB_TOP      3328
#define XB_TOPGEN   3392
#define XCD_BAR_WORDS 3456
#define XB_SPIN_CAP (1u << 18)
DI unsigned xb_ld(unsigned* p)              { return __hip_atomic_load(p, __ATOMIC_RELAXED, __HIP_MEMORY_SCOPE_AGENT); }
DI unsigned xb_add(unsigned* p, unsigned v) { return __hip_atomic_fetch_add(p, v, __ATOMIC_RELAXED, __HIP_MEMORY_SCOPE_AGENT); }
DI unsigned xb_xcc_id() { return (unsigned)__builtin_amdgcn_s_getreg((3 << 11) | 20) & 0xFu; }
#define XB_SPIN(cond, bar) do { unsigned _sp = 0; while (cond) { __builtin_amdgcn_s_sleep(1); \
    if ((++_sp & 255u) == 0u) { if (xb_ld(&(bar)[XB_TMO])) break; if (_sp > XB_SPIN_CAP) { atomicAdd(&(bar)[XB_TMO], 1u); break; } } } } while (0)
struct XcdBarrier { unsigned* bar; unsigned x; volatile LAS unsigned* st; };
DI XcdBarrier xcd_barrier_post(unsigned* bar, volatile LAS unsigned* st) {
    XcdBarrier b; b.bar = bar; b.x = xb_xcc_id(); b.st = st;
    if (threadIdx.x == 0) (void)xb_add(&bar[XB_XCNT(b.x)], 1u);
    return b;
}
DI void xcd_barrier_complete(unsigned* bar, unsigned x, unsigned& nloc, unsigned& nx) {
    const unsigned G = gridDim.x * gridDim.y * gridDim.z;
    unsigned sum, cnt, mine, sp = 0u;
    for (;;) {
        sum = 0u; cnt = 0u; mine = 0u;
#pragma unroll
        for (unsigned j = 0; j < 16; ++j) { const unsigned c = xb_ld(&bar[XB_XCNT(j)]); sum += c; cnt += (c > 0u) ? 1u : 0u; mine = (j == x) ? c : mine; }
        if (sum == G) break;
        __builtin_amdgcn_s_sleep(1);
        if ((++sp & 255u) == 0u) { if (xb_ld(&bar[XB_TMO])) break; if (sp > XB_SPIN_CAP) { atomicAdd(&bar[XB_TMO], 1u); break; } }
    }
    nloc = mine > 0u ? mine : 1u; nx = cnt > 0u ? cnt : 1u;
}
DI void xcd_barrier(const XcdBarrier& b) {
    asm volatile("s_waitcnt vmcnt(0)" ::: "memory");
    __syncthreads();
    if (threadIdx.x == 0) {
        unsigned* bar = b.bar;
        __builtin_amdgcn_s_waitcnt(0);
        unsigned nloc = b.st[0], nx = b.st[1];
        if (nloc == 0u) { xcd_barrier_complete(bar, b.x, nloc, nx); b.st[0] = nloc; b.st[1] = nx; }
        const unsigned old = xb_add(&bar[XB_XSUB(b.x)], 1u);
        const unsigned gen = old / nloc;
        if (old + 1u == (gen + 1u) * nloc) {
            __builtin_amdgcn_fence(__ATOMIC_RELEASE, "agent");
            asm volatile("s_waitcnt vmcnt(0)" ::: "memory");
            const unsigned og = xb_add(&bar[XB_TOP], 1u);
            const unsigned tg = og / nx;
            if (og + 1u == (tg + 1u) * nx) xb_add(&bar[XB_TOPGEN], 1u);
            else XB_SPIN(xb_ld(&bar[XB_TOPGEN]) == tg, bar);
            __builtin_amdgcn_fence(__ATOMIC_ACQUIRE, "agent");
            xb_add(&bar[XB_XGEN(b.x)], 1u);
            asm volatile("s_waitcnt vmcnt(0)" ::: "memory");
        } else {
            XB_SPIN(xb_ld(&bar[XB_XGEN(b.x)]) == gen, bar);
            __builtin_amdgcn_fence(__ATOMIC_ACQUIRE, "agent");
            asm volatile("s_waitcnt vmcnt(0)" ::: "memory");
        }
    }
    __syncthreads();
}

constexpr int NPHASE = 18;
__global__ void __launch_bounds__(512, 2) fwd_megakernel(Params p, int ph0, int ph1) {
    extern __shared__ __attribute__((aligned(16))) unsigned char shm[];
    __shared__ __attribute__((aligned(16))) unsigned xb_words[4];
    LAS unsigned char* lds = (LAS unsigned char*)shm;
    cg::grid_group grid = cg::this_grid();
    XcdBarrier xb; xb.bar = (unsigned*)(p.ws + OFF_BAR); xb.x = 0; xb.st = (volatile LAS unsigned*)xb_words;
    if (ph1 - ph0 > 1) { if (threadIdx.x < 4) xb_words[threadIdx.x] = 0u; __syncthreads(); xb = xcd_barrier_post((unsigned*)(p.ws + OFF_BAR), (volatile LAS unsigned*)xb_words); }
    pg8::StaticOrder S;
#define PHASE(k) if (((PH_MASK >> (k)) & 1) && ph0 <= (k) && (k) < ph1)
#define SYNC(k) if (ph0 <= (k) && (k) + 1 < ph1) { if (ph1 > NPHASE) grid.sync(); else xcd_barrier(xb); }
    PHASE(0) { phase_prep(p, shm); } SYNC(0);
    PHASE(1) {
        if (blockIdx.x < 64 && gridDim.x > 64) phase_transposes(p, shm, blockIdx.x, 64);
        else if (gridDim.x > 64) phase_h0(p, blockIdx.x - 64, gridDim.x - 64);
        else { phase_transposes(p, shm, blockIdx.x, gridDim.x); phase_h0(p, blockIdx.x, gridDim.x); }
    } SYNC(1);
    PHASE(2) {
        pg8::Gemm g = {(const u16*)(p.ws + OFF_R0), (const u16*)(p.ws + OFF_WT1), M, 3328, 1024, 1024, 1024, 0, 0};
        EpiBf16Split E; E.base[0] = (u16*)(p.ws + OFF_R1); E.base[1] = (u16*)(p.ws + OFF_R2); E.base[2] = (u16*)(p.ws + OFF_R3); E.split_tiles = 4; E.ldc = 1024; E.lr = (float*)(p.ws + OFF_LR); E.lr_tile = 12;
        S.init(g.M, g.N, gridDim.x, blockIdx.x); pg8::gemm_phase(lds, g, S, E);
    } SYNC(2);
    PHASE(3) { phase_gla_chunk(p, shm, p.out); } SYNC(3);
    PHASE(4) { phase_gla_seq<0>(p, shm, p.out); } SYNC(4);
    PHASE(5) { phase_gla_combine(p, MX, M, blockIdx.x, gridDim.x); } SYNC(5);
    PHASE(6) {
        if (blockIdx.x < 16) {
            pg8::Gemm g = {(const u16*)(p.ws + OFF_R4) + (size_t)MX * 1024, (const u16*)(p.ws + OFF_WT2), MC, 1024, 1024, 1024, 1024, 0, 0};
            EpiBf16Split E; E.base[0] = E.base[1] = E.base[2] = (u16*)(p.ws + OFF_Y); E.split_tiles = 64; E.ldc = 1024; E.lr = nullptr; E.lr_tile = -1; E.row_base = MX;
            S.init(g.M, g.N, 16, blockIdx.x); pg8::gemm_phase(lds, g, S, E);
        } else phase_gla_combine(p, 0, MX, blockIdx.x - 16, gridDim.x - 16);
    } SYNC(6);
    PHASE(7) {
        pg8::Gemm g = {(const u16*)(p.ws + OFF_R4), (const u16*)(p.ws + OFF_WT2), MX, 1024, 1024, 1024, 1024, 0, 0};
        EpiBf16Split E; E.base[0] = E.base[1] = E.base[2] = (u16*)(p.ws + OFF_Y); E.split_tiles = 64; E.ldc = 1024; E.lr = nullptr; E.lr_tile = -1;
        S.init(g.M, g.N, gridDim.x, blockIdx.x); pg8::gemm_phase(lds, g, S, E);
    } SYNC(7);
    PHASE(8) { phase_h1(p, MX, M, blockIdx.x, gridDim.x); } SYNC(8);
    PHASE(9) {
        if (blockIdx.x < 40) {
            pg8::Gemm g = {(const u16*)(p.ws + OFF_R0) + (size_t)MX * 1024, (const u16*)(p.ws + OFF_WT3), MC, 2560, 1024, 1024, 1024, 0, 0};
            EpiBf16Split E; E.base[0] = (u16*)(p.ws + OFF_Z); E.base[1] = E.base[2] = (u16*)(p.ws + OFF_G2); E.split_tiles = 5; E.ldc = 1280; E.lr = nullptr; E.lr_tile = -1; E.row_base = MX;
            S.init(g.M, g.N, 40, blockIdx.x); pg8::gemm_phase(lds, g, S, E);
        } else phase_h1(p, 0, MX, blockIdx.x - 40, gridDim.x - 40);
    } SYNC(9);
    PHASE(10) {
        pg8::Gemm g = {(const u16*)(p.ws + OFF_R0), (const u16*)(p.ws + OFF_WT3), MX, 2560, 1024, 1024, 1024, 0, 0};
        EpiBf16Split E; E.base[0] = (u16*)(p.ws + OFF_Z); E.base[1] = E.base[2] = (u16*)(p.ws + OFF_G2); E.split_tiles = 5; E.ldc = 1280; E.lr = nullptr; E.lr_tile = -1;
        S.init(g.M, g.N, gridDim.x, blockIdx.x); pg8::gemm_phase(lds, g, S, E);
    } SYNC(10);
    PHASE(11) { phase_conv(p, p.out); } SYNC(11);
    PHASE(12) {
        pg8::Gemm g = {(const u16*)p.out, (const u16*)(p.ws + OFF_WT4), M, 5120, 256, 1280, 256, 2, 512};
        EpiPair E; E.GA = (unsigned*)(p.ws + OFF_AU);
        S.init(g.M, g.N, gridDim.x, blockIdx.x); pg8::gemm_phase(lds, g, S, E);
    } SYNC(12);
    PHASE(13) { phase_lru_agg(p, p.out); } SYNC(13);
    PHASE(14) { phase_lru_carry(p); } SYNC(14);
    PHASE(15) { phase_lru_apply(p, shm, p.out); } SYNC(15);
    PHASE(16) {
        pg8::Gemm g = {(const u16*)p.out, (const u16*)(p.ws + OFF_WT5), MX, 1024, 1280, 1280, 1280, 0, 0};
        EpiBf16Split E; E.base[0] = E.base[1] = E.base[2] = (u16*)(p.ws + OFF_Y2); E.split_tiles = 64; E.ldc = 1024; E.lr = nullptr; E.lr_tile = -1;
        S.init(g.M, g.N, gridDim.x, blockIdx.x); pg8::gemm_phase(lds, g, S, E);
    } SYNC(16);
    PHASE(17) { phase_final(p); }
#undef PHASE
#undef SYNC
}

extern "C" void kernel_launch(void* const* d_in, const int* in_sizes, int n_in, void* d_out, int out_size, void* d_ws, size_t ws_size, hipStream_t stream) {
    constexpr size_t kDynLds = 131072;
    static int grid_blocks = 0;
    if (!grid_blocks) {
        hipFuncSetAttribute((const void*)fwd_megakernel, hipFuncAttributeMaxDynamicSharedMemorySize, (int)kDynLds);
        int dev = 0, cus = 0, per_cu = 0;
        hipGetDevice(&dev);
        hipDeviceGetAttribute(&cus, hipDeviceAttributeMultiprocessorCount, dev);
        hipOccupancyMaxActiveBlocksPerMultiprocessor(&per_cu, fwd_megakernel, 512, kDynLds);
        if (per_cu < 1) per_cu = 1;
        grid_blocks = cus * 1;
    }
    Params p{};
    for (int i = 0; i < 29; ++i) p.in[i] = (const float*)d_in[i];
    p.out = (float*)d_out; p.ws = (unsigned char*)d_ws;
#if MULTI_LAUNCH
    for (int k = 0; k < NPHASE; ++k) for (int rep = 0; rep <= ((REP_MASK >> k) & 1); ++rep) fwd_megakernel<<<dim3(grid_blocks), dim3(512), kDynLds, stream>>>(p, k, k + 1);
#else
    int ph0 = 0, ph1 = NPHASE;
    (void)hipMemsetAsync((unsigned char*)d_ws + OFF_BAR, 0, XCD_BAR_WORDS * sizeof(unsigned), stream);
    void* args[] = {&p, &ph0, &ph1};
    hipError_t e = hipLaunchCooperativeKernel((void*)fwd_megakernel, dim3(grid_blocks), dim3(512), args, kDynLds, stream);
    if (e != hipSuccess) fprintf(stderr, "cooperative launch failed: %s (grid %d)\n", hipGetErrorString(e), grid_blocks);
#endif
}
```

```cpp
#include <hip/hip_runtime.h>
#include <hip/hip_cooperative_groups.h>
#include <cstdio>
namespace cg = cooperative_groups;

#ifndef PH_MASK
#define PH_MASK 0xFFFFFF
#endif
#ifndef REP_MASK
#define REP_MASK 0
#endif
#ifndef EXTRA
#define EXTRA 0
#endif
#ifndef MULTI_LAUNCH
#define MULTI_LAUNCH 0
#endif

typedef unsigned short u16;
typedef short bf16x8 __attribute__((ext_vector_type(8)));
typedef float f32x4 __attribute__((ext_vector_type(4)));
typedef float f32x2 __attribute__((ext_vector_type(2)));
typedef unsigned u32x4 __attribute__((ext_vector_type(4)));
typedef unsigned u32x2 __attribute__((ext_vector_type(2)));
typedef __bf16 bfv2 __attribute__((ext_vector_type(2)));
#define LAS __attribute__((address_space(3)))
#define DI __device__ __forceinline__

constexpr int D = 1024, MX = 32768, MC = 1024, M = MX + MC;
constexpr int NCH = M / 64;
constexpr int LW = 1280;
constexpr size_t MiB = 1024 * 1024;
constexpr size_t OFF_Y = 0;
constexpr size_t OFF_R0 = 66 * MiB;
constexpr size_t OFF_R1 = 132 * MiB;
constexpr size_t OFF_R2 = 198 * MiB;
constexpr size_t OFF_R3 = 264 * MiB;
constexpr size_t OFF_R4 = 330 * MiB;
constexpr size_t OFF_VT = 396 * MiB;
constexpr size_t OFF_WT1 = 462 * MiB;
constexpr size_t OFF_WT2 = OFF_WT1 + 7 * MiB;
constexpr size_t OFF_LR = OFF_WT2 + 2 * MiB;
constexpr size_t OFF_EL = OFF_LR + 5 * MiB;
constexpr size_t OFF_MOD = 479 * MiB;
constexpr size_t OFF_WT3 = OFF_MOD + 1 * MiB;
constexpr size_t OFF_WT4 = OFF_WT3 + 5 * MiB;
constexpr size_t OFF_WT5 = OFF_WT4 + 3 * MiB;
constexpr size_t OFF_CA = OFF_WT5 + 3 * MiB;
constexpr size_t OFF_CU = OFF_CA + 6 * MiB;
constexpr size_t OFF_HS = OFF_CU + 6 * MiB;
constexpr size_t OFF_BAR = OFF_HS + 6 * MiB;
constexpr size_t OFF_AU = 66 * MiB;
constexpr size_t OFF_Z = 132 * MiB;
constexpr size_t OFF_G2 = 396 * MiB;
constexpr size_t OFF_Y2 = 66 * MiB;

struct Params {
    const float* in[29];
    float* out;
    unsigned char* ws;
};

template <class T> DI T ntload(const T* p) { return __builtin_nontemporal_load(p); }
template <class T> DI void ntstore(T v, T* p) { __builtin_nontemporal_store(v, p); }
DI float bf2f(u16 b) { return __uint_as_float(((unsigned)b) << 16); }
DI unsigned pk2(float lo, float hi) { f32x2 v = {lo, hi}; bfv2 b = __builtin_convertvector(v, bfv2); return __builtin_bit_cast(unsigned, b); }
DI u16 f2bf(float f) { return (u16)(pk2(f, 0.f) & 0xffffu); }
DI float lo_bf(unsigned w) { return __uint_as_float(w << 16); }
DI float hi_bf(unsigned w) { return __uint_as_float(w & 0xffff0000u); }
DI float wave_sum(float v) {
#pragma unroll
    for (int o = 32; o; o >>= 1) v += __shfl_xor(v, o);
    return v;
}
DI float fexp(float x) { return __builtin_amdgcn_exp2f(x * 1.4426950408889634f); }
DI float flog(float x) { return __builtin_amdgcn_logf(x) * 0.6931471805599453f; }
DI float sigmoid_f(float x) { return __builtin_amdgcn_rcpf(1.f + fexp(-x)); }
DI float silu_f(float x) { return x * sigmoid_f(x); }

namespace pg8 {
constexpr int BM = 256, BK = 64, HALF = 128, HTB = HALF * BK * 2, STAGE_BYTES = 8 * HTB, NXCD = 8, WGM = 8;
DI int lds_byte(int r, int c) { const int st = (r >> 4) * 2 + (c >> 5), rr = r & 15, cc = c & 31, ob = rr * 64 + cc * 2; return st * 1024 + (ob ^ (((ob >> 9) & 1) << 5)); }
DI void stage_rc(int b, int& R, int& C) { const int st = b / 1024, sb = b % 1024, swz = sb ^ (((sb >> 9) & 1) << 5); R = (st >> 1) * 16 + swz / 64; C = (st & 1) * 32 + (swz % 64) / 2; }
DI int perm32(int rho) { const int n = rho >> 4, i = rho & 15; return 8 * (i >> 2) + 4 * n + (i & 3); }
struct Unit { int pm, pn; };
struct Gemm { const u16* A; const u16* Bt; int M, N, K, lda, ldb, a_shift, a_colbytes; };
struct StaticOrder {
    int nM, nN, nwg, G, c;
    DI void init(int M_, int N_, int G_, int c_) { nM = M_ / BM; nN = N_ / BM; nwg = nM * nN; G = G_; c = c_; }
    DI bool next(int i, Unit& u) const {
        const long L = (long)i * G + c; if (L >= nwg) return false;
        int wgid = (int)L; { const int q = nwg / NXCD, r = nwg % NXCD, xcd = wgid % NXCD, off = wgid / NXCD; wgid = (xcd < r ? xcd * (q + 1) : r * (q + 1) + (xcd - r) * q) + off; }
        const int nig = WGM * nN, gid = wgid / nig, fm = gid * WGM, gsz = (nM - fm) < WGM ? (nM - fm) : WGM;
        u.pm = fm + ((wgid % nig) % gsz); u.pn = (wgid % nig) / gsz; return true;
    }
};

template <class Epi>
DI void gemm_phase(LAS unsigned char* lds, const Gemm g, const StaticOrder& S, const Epi& E) {
    const int tid = threadIdx.x, wid = __builtin_amdgcn_readfirstlane(tid >> 6), lane = tid & 63, wr = wid >> 2, wc = wid & 3, fr = lane & 15, fq = lane >> 4;
    const int K = g.K, nt = K / BK;
    unsigned voffA[2], voffB[2];
#pragma unroll
    for (int i = 0; i < 2; ++i) { int R, C; stage_rc(tid * 16 + i * 8192, R, C); const int Rb = Epi::PERM ? ((R & ~31) + perm32(R & 31)) : R;
        voffA[i] = (unsigned)(R * g.lda + C) * 2u; voffB[i] = (unsigned)(Rb * g.ldb + C) * 2u; }
    const size_t kstep = (size_t)(BK * 2);
    const size_t hstepA = (size_t)HALF * g.lda * 2, hstepB = (size_t)HALF * g.ldb * 2;
    const unsigned ldsw = (unsigned)wid * 1024u;
    const int aoff = lds_byte(wr * 64 + fr, fq * 8), boff = lds_byte(wc * 32 + fr, fq * 8);
#define PG8_SA(b, h) (((b) * 2 + (h)) * HTB)
#define PG8_SB(b, h) ((4 + (b) * 2 + (h)) * HTB)
#define PG8_STAGE(bufoff, gbase, voff) do { _Pragma("unroll") for (int _i = 0; _i < 2; ++_i) \
        __builtin_amdgcn_global_load_lds((const unsigned*)((const char*)(gbase) + (voff)[_i]), (LAS unsigned*)(lds + (bufoff) + ldsw + _i * 8192), 16, 0, 0); } while (0)
#define PG8_LDA(dst, b, h) do { _Pragma("unroll") for (int m = 0; m < 4; ++m) _Pragma("unroll") for (int k = 0; k < 2; ++k) dst[m][k] = *(const LAS bf16x8*)(lds + PG8_SA(b, h) + aoff + m * 2048 + k * 1024); } while (0)
#define PG8_LDB(dst, b, h) do { _Pragma("unroll") for (int n = 0; n < 2; ++n) _Pragma("unroll") for (int k = 0; k < 2; ++k) dst[n][k] = *(const LAS bf16x8*)(lds + PG8_SB(b, h) + boff + n * 2048 + k * 1024); } while (0)
#define PG8_MMA(ai, bj, At, Bt) do { __builtin_amdgcn_s_setprio(1); _Pragma("unroll") for (int m = 0; m < 4; ++m) _Pragma("unroll") for (int n = 0; n < 2; ++n) _Pragma("unroll") for (int k = 0; k < 2; ++k) \
        acc[ai][bj][m][n] = __builtin_amdgcn_mfma_f32_16x16x32_bf16(Bt[n][k], At[m][k], acc[ai][bj][m][n], 0, 0, 0); __builtin_amdgcn_s_setprio(0); } while (0)
#define PG8_WAIT_V(n) asm volatile("s_waitcnt vmcnt(" #n ")" ::: "memory")
#define PG8_WAIT_L(n) asm volatile("s_waitcnt lgkmcnt(" #n ")" ::: "memory")
#define PG8_BAR __builtin_amdgcn_s_barrier()
#define PG8_SCHED __builtin_amdgcn_sched_barrier(0)
#define PG8_APTR(u) ((const char*)g.A + (size_t)(u).pm * 2 * hstepA + (size_t)((u).pn >> g.a_shift) * g.a_colbytes)
#define PG8_BPTR(u) ((const char*)g.Bt + (size_t)(u).pn * 2 * hstepB)
    Unit cur, nxt; int ui = 0;
    if (!S.next(0, cur)) return;
    f32x4 acc[2][2][4][2];
#pragma unroll
    for (int a = 0; a < 2; ++a)
#pragma unroll
        for (int b = 0; b < 2; ++b)
#pragma unroll
            for (int m = 0; m < 4; ++m)
#pragma unroll
                for (int n = 0; n < 2; ++n) acc[a][b][m][n] = (f32x4){0.f, 0.f, 0.f, 0.f};
    bf16x8 At[4][2], B0[2][2], B1[2][2];
    const char* cA = PG8_APTR(cur); const char* cB = PG8_BPTR(cur);
    PG8_STAGE(PG8_SB(0, 0), cB, voffB); PG8_STAGE(PG8_SA(0, 0), cA, voffA); PG8_STAGE(PG8_SB(0, 1), cB + hstepB, voffB); PG8_STAGE(PG8_SA(0, 1), cA + hstepA, voffA);
    if (wr == 1) PG8_BAR;
    PG8_WAIT_V(4); PG8_BAR;
    PG8_STAGE(PG8_SB(1, 0), cB + kstep, voffB); PG8_STAGE(PG8_SA(1, 0), cA + kstep, voffA); PG8_STAGE(PG8_SB(1, 1), cB + hstepB + kstep, voffB);
    PG8_WAIT_V(6); PG8_BAR;
    for (;;) {
        const bool has_next = S.next(ui + 1, nxt);
        const char* nA = has_next ? PG8_APTR(nxt) : cA; const char* nB = has_next ? PG8_BPTR(nxt) : cB;
        for (int t = 0; t < nt; t += 2) {
            const bool last = (t == nt - 2);
            const char* a1 = cA + (size_t)(t + 1) * kstep;
            const char* a2 = last ? nA : cA + (size_t)(t + 2) * kstep; const char* b2 = last ? nB : cB + (size_t)(t + 2) * kstep;
            const char* a3 = a2 + kstep; const char* b3 = b2 + kstep;
            PG8_LDB(B0, 0, 0); PG8_SCHED; PG8_LDA(At, 0, 0); PG8_STAGE(PG8_SA(1, 1), a1 + hstepA, voffA);
            PG8_WAIT_L(8); PG8_BAR; PG8_WAIT_L(0); PG8_MMA(0, 0, At, B0); PG8_BAR; PG8_SCHED;
            PG8_LDB(B1, 0, 1); PG8_STAGE(PG8_SB(0, 0), b2, voffB);
            PG8_BAR; PG8_WAIT_L(0); PG8_MMA(0, 1, At, B1); PG8_BAR;
            PG8_LDA(At, 0, 1); PG8_STAGE(PG8_SA(0, 0), a2, voffA);
            PG8_BAR; PG8_WAIT_L(0); PG8_MMA(1, 0, At, B0); PG8_BAR; PG8_SCHED;
            PG8_STAGE(PG8_SB(0, 1), b2 + hstepB, voffB);
            PG8_WAIT_V(6); PG8_BAR; PG8_MMA(1, 1, At, B1); PG8_BAR;
            PG8_LDB(B0, 1, 0); PG8_SCHED; PG8_LDA(At, 1, 0); PG8_STAGE(PG8_SA(0, 1), a2 + hstepA, voffA);
            PG8_WAIT_L(8); PG8_BAR; PG8_WAIT_L(0); PG8_MMA(0, 0, At, B0); PG8_BAR; PG8_SCHED;
            PG8_LDB(B1, 1, 1); PG8_STAGE(PG8_SB(1, 0), b3, voffB);
            PG8_BAR; PG8_WAIT_L(0); PG8_MMA(0, 1, At, B1); PG8_BAR;
            PG8_LDA(At, 1, 1); PG8_STAGE(PG8_SA(1, 0), a3, voffA);
            PG8_BAR; PG8_WAIT_L(0); PG8_MMA(1, 0, At, B0); PG8_BAR; PG8_SCHED;
            PG8_STAGE(PG8_SB(1, 1), b3 + hstepB, voffB);
            PG8_WAIT_V(6); PG8_BAR; PG8_MMA(1, 1, At, B1); PG8_BAR;
        }
        E(acc, cur, wr, wc, fr, fq);
        if (!has_next) break;
#pragma unroll
        for (int a = 0; a < 2; ++a)
#pragma unroll
            for (int b = 0; b < 2; ++b)
#pragma unroll
                for (int m = 0; m < 4; ++m)
#pragma unroll
                    for (int n = 0; n < 2; ++n) acc[a][b][m][n] = (f32x4){0.f, 0.f, 0.f, 0.f};
        cur = nxt; cA = nA; cB = nB; ++ui;
    }
    PG8_WAIT_V(0);
    if (wr == 0) PG8_BAR;
    PG8_BAR;
#undef PG8_SA
#undef PG8_SB
#undef PG8_STAGE
#undef PG8_LDA
#undef PG8_LDB
#undef PG8_MMA
#undef PG8_WAIT_V
#undef PG8_WAIT_L
#undef PG8_BAR
#undef PG8_SCHED
#undef PG8_APTR
#undef PG8_BPTR
}
}
using pg8::Unit;

struct EpiBf16Split {
    static constexpr bool PERM = true;
    u16* base[3]; int split_tiles; int ldc; float* lr; int lr_tile;
    int row_base = 0;
    DI void operator()(const f32x4 (&acc)[2][2][4][2], const Unit& u, int wr, int wc, int fr, int fq) const {
        const int row0 = row_base + u.pm * 256 + wr * 64 + fr;
        if (u.pn == lr_tile) {
            if (wc == 0) {
#pragma unroll
                for (int ai = 0; ai < 2; ++ai)
#pragma unroll
                    for (int m = 0; m < 4; ++m) { float* rp = lr + (size_t)(row0 + ai * 128 + m * 16) * 32 + 8 * fq;
                        *(f32x4*)(rp) = acc[ai][0][m][0]; *(f32x4*)(rp + 4) = acc[ai][0][m][1]; }
            }
            return;
        }
        const int t = u.pn / split_tiles; u16* b = t == 0 ? base[0] : (t == 1 ? base[1] : base[2]);
        const int col0 = (u.pn - t * split_tiles) * 256 + wc * 32 + 8 * fq;
#pragma unroll
        for (int ai = 0; ai < 2; ++ai)
#pragma unroll
            for (int m = 0; m < 4; ++m) { u16* rowp = b + (size_t)(row0 + ai * 128 + m * 16) * ldc + col0;
#pragma unroll
                for (int bj = 0; bj < 2; ++bj) { const f32x4 v0 = acc[ai][bj][m][0], v1 = acc[ai][bj][m][1];
                    u32x4 w; w.x = pk2(v0[0], v0[1]); w.y = pk2(v0[2], v0[3]); w.z = pk2(v1[0], v1[1]); w.w = pk2(v1[2], v1[3]);
                    *(u32x4*)(rowp + bj * 128) = w; } }
    }
};
struct EpiPair {
    static constexpr bool PERM = true;
    unsigned* GA;
    DI void operator()(const f32x4 (&acc)[2][2][4][2], const Unit& u, int wr, int wc, int fr, int fq) const {
        const int blk = u.pn >> 2, dir = (u.pn >> 1) & 1, half = u.pn & 1;
        const int row0 = u.pm * 256 + wr * 64 + fr;
        unsigned* ga = GA + (size_t)dir * M * LW + blk * 256 + half * 128 + wc * 32 + 8 * fq;
#pragma unroll
        for (int ai = 0; ai < 2; ++ai)
#pragma unroll
            for (int m = 0; m < 4; ++m) { unsigned* rp = ga + (size_t)(row0 + ai * 128 + m * 16) * LW;
#pragma unroll
                for (int n = 0; n < 2; ++n) { u32x4 w;
#pragma unroll
                    for (int j = 0; j < 4; ++j) w[j] = pk2(acc[ai][0][m][n][j], acc[ai][1][m][n][j]);
                    *(u32x4*)(rp + 4 * n) = w; } }
    }
};
DI void gate_au(unsigned w, float z, float ba, float bx, float c8, float& a, float& u) {
    const float r = sigmoid_f(lo_bf(w) + ba), ig = sigmoid_f(hi_bf(w) + bx);
    a = fexp(-c8 * r); u = __builtin_amdgcn_sqrtf(fmaxf(1.f - a * a, 0.f)) * ig * z;
}

DI void phase_prep(const Params& p, unsigned char* shm) {
    const int tid = threadIdx.x;
    float* scS = (float*)shm;
    float* red = scS + 5 * 1024;
    float* MOD = (float*)(p.ws + OFF_MOD);
    for (int i = tid; i < 5 * 1024; i += 512) { const int v = i >> 10, k = i & 1023; const float cv = v < 4 ? p.in[1][v * 1024 + k] : p.in[3][k]; scS[i] = silu_f(cv); }
    __syncthreads();
    for (int item = blockIdx.x; item < 192; item += gridDim.x) {
        const int layer = item / 96, n0 = (item % 96) * 32, col = tid & 31, kg = tid >> 5;
        float a0 = 0.f, a1 = 0.f, a2 = 0.f, a3 = 0.f, a4 = 0.f;
        const float* w = p.in[4] + (size_t)layer * 1024 * 3072 + n0 + col;
#pragma unroll 16
        for (int kk = 0; kk < 64; ++kk) { const int k = kg * 64 + kk; const float wv = w[(size_t)k * 3072];
            a0 += scS[k] * wv; a1 += scS[1024 + k] * wv; a2 += scS[2048 + k] * wv; a3 += scS[3072 + k] * wv; a4 += scS[4096 + k] * wv; }
        red[(kg * 5 + 0) * 32 + col] = a0; red[(kg * 5 + 1) * 32 + col] = a1; red[(kg * 5 + 2) * 32 + col] = a2; red[(kg * 5 + 3) * 32 + col] = a3; red[(kg * 5 + 4) * 32 + col] = a4;
        __syncthreads();
        if (tid < 160) { const int v = tid >> 5, c2 = tid & 31; float s = 0.f;
#pragma unroll
            for (int q = 0; q < 16; ++q) s += red[(q * 5 + v) * 32 + c2];
            MOD[(layer * 5 + v) * 3072 + n0 + c2] = s + p.in[5][layer * 3072 + n0 + c2]; }
        __syncthreads();
    }
}
DI void phase_transposes(const Params& p, unsigned char* shm, int wgi, int nwg) {
    const int tid = threadIdx.x;
    float* tile = (float*)shm;
    constexpr int T0 = 16 * 49, T1 = T0 + 256, T2 = T1 + 640, T3 = T2 + 320, T4 = T3 + 320;
    for (int tb = wgi; tb < T4; tb += 4 * nwg) {
        const float* src[4]; u16* dst[4]; int sld[4], dld[4], Nn[4], k0[4], n0[4]; bool valid[4];
#pragma unroll
        for (int u = 0; u < 4; ++u) {
            const int tl = tb + u * nwg; valid[u] = tl < T4; const int tc = valid[u] ? tl : 0; int kt, ntl;
            if (tc < T0) { kt = tc / 49; ntl = tc % 49; src[u] = p.in[8]; sld[u] = 3104; Nn[u] = 3104; dst[u] = (u16*)(p.ws + OFF_WT1); dld[u] = 1024; }
            else if (tc < T1) { const int t = tc - T0; kt = t / 16; ntl = t % 16; src[u] = p.in[14]; sld[u] = 1024; Nn[u] = 1024; dst[u] = (u16*)(p.ws + OFF_WT2); dld[u] = 1024; }
            else if (tc < T2) { const int t = tc - T1; kt = t / 40; ntl = t % 40; src[u] = p.in[15]; sld[u] = 2560; Nn[u] = 2560; dst[u] = (u16*)(p.ws + OFF_WT3); dld[u] = 1024; }
            else if (tc < T3) { const int t = tc - T2; kt = t / 16; ntl = t % 16; src[u] = p.in[28]; sld[u] = 1024; Nn[u] = 1024; dst[u] = (u16*)(p.ws + OFF_WT5); dld[u] = 1280; }
            else { const int t = tc - T3; const int j = t >> 3, tt = t & 7; kt = tt >> 1; ntl = tt & 1;
                const int gate = j / 10, rem = j % 10, blk = rem >> 1, half = rem & 1, dir = gate >> 1, isx = gate & 1;
                const float* gp = gate == 0 ? p.in[18] : (gate == 1 ? p.in[20] : (gate == 2 ? p.in[23] : p.in[25]));
                src[u] = gp + blk * 65536 + half * 128; sld[u] = 256; Nn[u] = 128;
                dst[u] = (u16*)(p.ws + OFF_WT4) + (size_t)((blk * 4 + dir * 2 + half) * 256 + isx * 128) * 256; dld[u] = 256; }
            k0[u] = kt * 64; n0[u] = ntl * 64;
        }
        float v[4][8];
#pragma unroll
        for (int u = 0; u < 4; ++u)
#pragma unroll
            for (int i = 0; i < 8; ++i) { const int e = tid + i * 512, kr = e >> 6, nc = e & 63;
                v[u][i] = (n0[u] + nc < Nn[u]) ? src[u][(size_t)(k0[u] + kr) * sld[u] + n0[u] + nc] : 0.f; }
        __syncthreads();
#pragma unroll
        for (int u = 0; u < 4; ++u)
#pragma unroll
            for (int i = 0; i < 8; ++i) { const int e = tid + i * 512, kr = e >> 6, nc = e & 63; tile[u * 4160 + kr * 65 + nc] = v[u][i]; }
        __syncthreads();
#pragma unroll
        for (int u = 0; u < 4; ++u) if (valid[u]) {
#pragma unroll
            for (int i = 0; i < 4; ++i) { const int pi = tid + i * 512, nr = pi >> 5, kc = (pi & 31) * 2;
                if (n0[u] + nr < Nn[u]) *(unsigned*)(dst[u] + (size_t)(n0[u] + nr) * dld[u] + k0[u] + kc) = pk2(tile[u * 4160 + kc * 65 + nr], tile[u * 4160 + (kc + 1) * 65 + nr]); } }
    }
}

DI const float* row_src(const Params& p, int row) { return row < MX ? p.in[0] + (size_t)row * D : p.in[2] + (size_t)(row - MX) * D; }
DI int row_perm(int row) { if (row >= MX) return row; const int b = row >> 13, t = row & 8191; return (b << 13) + (t & 63) * 128 + (t >> 6); }

DI void phase_h0(const Params& p, int wgi, int nwg) {
    const int wave = threadIdx.x >> 6, lane = threadIdx.x & 63;
    const float* MOD = (const float*)(p.ws + OFF_MOD);
    u16* H = (u16*)(p.ws + OFF_R0);
    for (int row = wgi * 16 + wave * 2; row < M; row += nwg * 16) {
        const int vec = row < MX ? row >> 13 : 4;
        const float* mod = MOD + (size_t)vec * 3072;
        f32x4 v[2][4]; float ss[2] = {0.f, 0.f};
#pragma unroll
        for (int r = 0; r < 2; ++r) { const float* src = row_src(p, row + r);
#pragma unroll
            for (int i = 0; i < 4; ++i) v[r][i] = ntload((const f32x4*)(src + i * 256 + lane * 4)); }
#pragma unroll
        for (int r = 0; r < 2; ++r) {
#pragma unroll
            for (int i = 0; i < 4; ++i) ss[r] += v[r][i][0] * v[r][i][0] + v[r][i][1] * v[r][i][1] + v[r][i][2] * v[r][i][2] + v[r][i][3] * v[r][i][3];
            ss[r] = rsqrtf(wave_sum(ss[r]) * (1.f / 1024.f) + 1e-6f); }
#pragma unroll
        for (int i = 0; i < 4; ++i) { const int c = i * 256 + lane * 4;
            const f32x4 g = *(const f32x4*)(p.in[6] + c), sh = *(const f32x4*)(mod + c), sc = *(const f32x4*)(mod + 1024 + c);
#pragma unroll
            for (int r = 0; r < 2; ++r) { float o[4];
#pragma unroll
                for (int j = 0; j < 4; ++j) o[j] = v[r][i][j] * ss[r] * g[j] * (1.f + sc[j]) + sh[j];
                u32x2 w; w.x = pk2(o[0], o[1]); w.y = pk2(o[2], o[3]); *(u32x2*)(H + (size_t)(row + r) * D + c) = w; } }
    }
}

DI void phase_gla_chunk(const Params& p, unsigned char* shm, float* outbuf) {
    const int tid = threadIdx.x, wave = tid >> 6, lane = tid & 63, l15 = lane & 15, lg4 = lane >> 4;
    float* lrS = (float*)shm;
    float* wgS = lrS + 64 * 32;
    float* bgS = wgS + 2 * 16 * 128;
    float* totS = bgS + 256;
    u16* qtS = (u16*)(totS + 512);
    u16* kbS = qtS + 64 * 136;
    u16* PS = kbS + 64 * 136;
    u16* vTS = PS + 64 * 72;
    u16* ktS = vTS + 256 * 72;
    const float* LR = (const float*)(p.ws + OFF_LR);
    const u16* QK = (const u16*)(p.ws + OFF_R1);
    const u16* V = (const u16*)(p.ws + OFF_R2);
    u16* QX = (u16*)(p.ws + OFF_R4);
    u16* KT = (u16*)outbuf;
    u16* VT = (u16*)(p.ws + OFF_VT);
    float* EL = (float*)(p.ws + OFF_EL);
    u16* OINTRA = (u16*)(p.ws + OFF_R0);
    int h_loaded = -1;
    for (int item = blockIdx.x; item < NCH * 4; item += gridDim.x) {
        const int cidx = item >> 2, h = item & 3, row0 = cidx * 64;
        u16 qraw[16], kraw[16], vraw[32]; float lrv[4];
        { const u16* qp = QK + (size_t)(row0 + (tid >> 7) * 16) * D + h * 128 + (tid & 127);
#pragma unroll
          for (int tt = 0; tt < 16; ++tt) { qraw[tt] = ntload(qp + (size_t)tt * D); kraw[tt] = ntload(qp + (size_t)tt * D + 512); }
          const u16* vp = V + (size_t)(row0 + (tid >> 8) * 32) * D + h * 256 + (tid & 255);
#pragma unroll
          for (int t2 = 0; t2 < 32; ++t2) vraw[t2] = ntload(vp + (size_t)t2 * D);
#pragma unroll
          for (int i = 0; i < 4; ++i) lrv[i] = ntload(LR + (size_t)row0 * 32 + tid + i * 512); }
        if (h != h_loaded) {
            float wv[8]; float bv = 0.f;
#pragma unroll
            for (int i = 0; i < 8; ++i) { const int e = tid + i * 512, d = e >> 11, r = (e >> 7) & 15, k = e & 127; wv[i] = (d ? p.in[11] : p.in[9])[r * 512 + h * 128 + k]; }
            if (tid < 256) { const int d = tid >> 7, k = tid & 127; bv = (d ? p.in[12] : p.in[10])[h * 128 + k]; }
#pragma unroll
            for (int i = 0; i < 8; ++i) wgS[tid + i * 512] = wv[i];
            if (tid < 256) bgS[tid] = bv;
            h_loaded = h;
        }
#pragma unroll
        for (int i = 0; i < 4; ++i) lrS[tid + i * 512] = lrv[i];
        {
            const int v = tid & 255, th = tid >> 8;
            unsigned pw[16];
#pragma unroll
            for (int t2 = 0; t2 < 16; ++t2) pw[t2] = (unsigned)vraw[2 * t2] | ((unsigned)vraw[2 * t2 + 1] << 16);
#pragma unroll
            for (int q = 0; q < 4; ++q) { const u32x4 w = {pw[4 * q], pw[4 * q + 1], pw[4 * q + 2], pw[4 * q + 3]};
                *(u32x4*)(vTS + v * 72 + th * 32 + q * 8) = w; }
        }
        __syncthreads();
        {
            u16* g = VT + (size_t)(cidx * 4 + h) * 16384;
#pragma unroll
            for (int j = 0; j < 4; ++j) { const int id = tid + j * 512; *(u32x4*)(g + id * 8) = *(const u32x4*)(vTS + (id >> 3) * 72 + (id & 7) * 8); }
        }
        f32x4 pacc[2] = {{0.f, 0.f, 0.f, 0.f}, {0.f, 0.f, 0.f, 0.f}};
#pragma unroll
        for (int dir = 0; dir < 2; ++dir) {
            const int k = tid & 127, tg = tid >> 7;
            float wreg[16];
#pragma unroll
            for (int r = 0; r < 16; ++r) wreg[r] = wgS[(dir * 16 + r) * 128 + k];
            const float bgv = bgS[dir * 128 + k];
            float lg[16];
#pragma unroll
            for (int tt = 0; tt < 16; ++tt) { const int t = tg * 16 + tt; float z = bgv;
#pragma unroll
                for (int r = 0; r < 16; ++r) z += lrS[t * 32 + dir * 16 + r] * wreg[r];
                lg[tt] = -(fmaxf(-z, 0.f) + flog(1.f + fexp(-fabsf(z)))) * (1.f / 16.f); }
            float run = 0.f;
            if (dir == 0) {
#pragma unroll
                for (int tt = 0; tt < 16; ++tt) { run += lg[tt]; lg[tt] = run; }
            } else {
#pragma unroll
                for (int tt = 15; tt >= 0; --tt) { run += lg[tt]; lg[tt] = run; }
            }
            totS[tg * 128 + k] = run;
            __syncthreads();
            float off = 0.f, total = 0.f;
#pragma unroll
            for (int g2 = 0; g2 < 4; ++g2) { const float tv = totS[g2 * 128 + k]; total += tv; if (dir == 0 ? (g2 < tg) : (g2 > tg)) off += tv; }
            unsigned kh[8];
            u16* qx = QX + (size_t)dir * M * 512;
#pragma unroll
            for (int t2 = 0; t2 < 8; ++t2) {
                float khv[2];
#pragma unroll
                for (int e = 0; e < 2; ++e) { const int tt = 2 * t2 + e, t = tg * 16 + tt;
                    const float cum = lg[tt] + off;
                    const float qv = bf2f(qraw[tt]) * 0.08838834764831845f;
                    const float kv = bf2f(kraw[tt]);
                    const u16 qt = f2bf(qv * fexp(cum));
                    qtS[t * 136 + k] = qt;
                    kbS[t * 136 + k] = f2bf(kv * fexp(-cum));
                    khv[e] = kv * fexp(total - cum); }
                kh[t2] = pk2(khv[0], khv[1]);
            }
            { const u32x4 w0 = {kh[0], kh[1], kh[2], kh[3]}, w1 = {kh[4], kh[5], kh[6], kh[7]};
              *(u32x4*)(ktS + k * 72 + tg * 16) = w0; *(u32x4*)(ktS + k * 72 + tg * 16 + 8) = w1; }
            if (tg == 0) EL[((size_t)dir * NCH + cidx) * 512 + h * 128 + k] = fexp(total);
            __syncthreads();
            {
#pragma unroll
                for (int j = 0; j < 2; ++j) { const int id = tid + j * 512;
                    { const int t_ = id >> 4, pc = id & 15, ks_ = pc >> 2, d_ = pc & 3;
                      const u32x2 lo = *(const u32x2*)(qtS + t_ * 136 + ks_ * 32 + 4 * d_), hi = *(const u32x2*)(qtS + t_ * 136 + ks_ * 32 + 16 + 4 * d_);
                      const u32x4 w = {lo.x, lo.y, hi.x, hi.y};
                      *(u32x4*)(qx + (size_t)(row0 + t_) * 512 + h * 128 + pc * 8) = w; }
                    *(u32x4*)(KT + (((size_t)dir * NCH + cidx) * 4 + h) * 8192 + id * 8) = *(const u32x4*)(ktS + (id >> 3) * 72 + (id & 7) * 8); }
            }
#pragma unroll
            for (int x = 0; x < 2; ++x) { const int id = wave * 2 + x, it = id >> 2, jt = id & 3;
                if (dir == 0 ? (jt <= it) : (jt >= it)) {
                    f32x4 a4 = {0.f, 0.f, 0.f, 0.f};
#pragma unroll
                    for (int ks = 0; ks < 4; ++ks) { const bf16x8 a = *(const bf16x8*)(qtS + (it * 16 + l15) * 136 + ks * 32 + lg4 * 8);
                        const bf16x8 b = *(const bf16x8*)(kbS + (jt * 16 + l15) * 136 + ks * 32 + lg4 * 8);
                        a4 = __builtin_amdgcn_mfma_f32_16x16x32_bf16(a, b, a4, 0, 0, 0); }
#pragma unroll
                    for (int r = 0; r < 4; ++r) { const int i = it * 16 + lg4 * 4 + r, j = jt * 16 + l15;
                        const bool keep = dir == 0 ? (j <= i) : (j >= i); pacc[x][r] += keep ? a4[r] : 0.f; }
                }
            }
            __syncthreads();
        }
#pragma unroll
        for (int x = 0; x < 2; ++x) { const int id = wave * 2 + x, it = id >> 2, jt = id & 3;
#pragma unroll
            for (int r = 0; r < 4; ++r) PS[(it * 16 + lg4 * 4 + r) * 72 + jt * 16 + l15] = f2bf(pacc[x][r]); }
        __syncthreads();
#pragma unroll
        for (int x = 0; x < 2; ++x) { const int vt = wave * 2 + x;
            const bf16x8 av0 = *(const bf16x8*)(vTS + (vt * 16 + l15) * 72 + lg4 * 8), av1 = *(const bf16x8*)(vTS + (vt * 16 + l15) * 72 + 32 + lg4 * 8);
#pragma unroll
            for (int it = 0; it < 4; ++it) {
                const bf16x8 b0 = *(const bf16x8*)(PS + (it * 16 + l15) * 72 + lg4 * 8), b1 = *(const bf16x8*)(PS + (it * 16 + l15) * 72 + 32 + lg4 * 8);
                f32x4 a4 = {0.f, 0.f, 0.f, 0.f};
                a4 = __builtin_amdgcn_mfma_f32_16x16x32_bf16(av0, b0, a4, 0, 0, 0);
                a4 = __builtin_amdgcn_mfma_f32_16x16x32_bf16(av1, b1, a4, 0, 0, 0);
                u32x2 w; w.x = pk2(a4[0], a4[1]); w.y = pk2(a4[2], a4[3]);
                *(u32x2*)(OINTRA + (size_t)(row0 + it * 16 + l15) * D + h * 256 + vt * 16 + lg4 * 4) = w; }
        }
        __syncthreads();
    }
}

template <int MODE> DI void phase_gla_seq(const Params& p, unsigned char* shm, const float* outbuf) {
    const int tid = threadIdx.x, wave = __builtin_amdgcn_readfirstlane(tid >> 6), lane = tid & 63, l15 = lane & 15, lg4 = lane >> 4;
    constexpr int QS_B = 64 * 288, KS_B = 128 * 144, VS_B = 32 * 144, BUF_B = QS_B + KS_B + VS_B + 512;
    constexpr int SF_OFF = 2 * BUF_B, SF_B = 8192;
    const u16* VT = (const u16*)(p.ws + OFF_VT);
    const float* ELb = (const float*)(p.ws + OFF_EL);
#define SEQ_BAR() do { __builtin_amdgcn_fence(__ATOMIC_RELEASE, "workgroup"); __builtin_amdgcn_s_barrier(); __builtin_amdgcn_fence(__ATOMIC_ACQUIRE, "workgroup"); } while (0)
    for (int item0 = blockIdx.x; item0 < 256; item0 += gridDim.x) {
        const int item = (((item0 & 7) * 4 + (item0 >> 6)) << 3) | ((item0 >> 3) & 7);
        const int vs = item & 7, dir = (item >> 3) & 1, h = (item >> 4) & 3, b = item >> 6;
        const unsigned char* QX = (const unsigned char*)((const u16*)(p.ws + OFF_R4) + (size_t)dir * M * 512 + h * 128);
        const unsigned char* KT = (const unsigned char*)((const u16*)outbuf + (size_t)dir * NCH * 4 * 8192 + (size_t)h * 8192);
        const unsigned char* VTb = (const unsigned char*)(VT + (size_t)h * 16384 + vs * 32 * 64);
        const unsigned char* EL = (const unsigned char*)(ELb + (size_t)dir * NCH * 512 + h * 128);
        u16* OI = (u16*)(p.ws + (dir ? OFF_R2 : OFF_R1));
#define SEQ_CIDX(s) ((s) < 4 ? 512 + 4 * b + (dir ? 3 - (s) : (s)) : 128 * b + (dir ? 127 - ((s) - 4) : ((s) - 4)))
        __syncthreads();
        *(u32x4*)(shm + SF_OFF + tid * 16) = (u32x4){0u, 0u, 0u, 0u};
        if (wave >= 4) {
            const int lt = tid - 256;
            unsigned soff[10], doff[10]; int kind[10];
#pragma unroll
            for (int i = 0; i < 10; ++i) { int id = lt + i * 256; if (id > 2335) id = 2335;
                if (id < 1024) { kind[i] = 0; soff[i] = (unsigned)((id >> 4) * 1024 + (id & 15) * 16); doff[i] = (unsigned)((id >> 4) * 288 + (id & 15) * 16); }
                else if (id < 2048) { const int j = id - 1024; kind[i] = 1; soff[i] = (unsigned)(j * 16); doff[i] = (unsigned)(QS_B + (j >> 3) * 144 + (j & 7) * 16); }
                else if (id < 2304) { const int j = id - 2048; kind[i] = 2; soff[i] = (unsigned)(j * 16); doff[i] = (unsigned)(QS_B + KS_B + (j >> 3) * 144 + (j & 7) * 16); }
                else { const int j = id - 2304; kind[i] = 3; soff[i] = (unsigned)(j * 16); doff[i] = (unsigned)(QS_B + KS_B + VS_B + j * 16); } }
            const bool last_valid = (lt + 9 * 256) < 2336;
            u32x4 ra[10], rb[10], rc[10], rd[10];
#define SEQ_LOAD(R, s) do { const int sl_ = (s) < 132 ? (s) : 131; const int ci = SEQ_CIDX(sl_); \
                const unsigned char* b0 = QX + (size_t)ci * 65536; const unsigned char* b1 = KT + (size_t)ci * 65536; \
                const unsigned char* b2 = VTb + (size_t)ci * 131072; const unsigned char* b3 = EL + (size_t)ci * 2048; \
                _Pragma("unroll") for (int i = 0; i < 10; ++i) { const unsigned char* bp = kind[i] == 0 ? b0 : (kind[i] == 1 ? b1 : (kind[i] == 2 ? b2 : b3)); \
                    if (i == 8) R[i] = ntload((const u32x4*)(bp + soff[i]));   \
                    else R[i] = *(const u32x4*)(bp + soff[i]); } } while (0)
#define SEQ_STORE(R, bi) do { unsigned char* bb = shm + (bi) * BUF_B; \
                _Pragma("unroll") for (int i = 0; i < 9; ++i) *(u32x4*)(bb + doff[i]) = R[i]; \
                *(u32x4*)(last_valid ? bb + doff[9] : shm + SF_OFF + 2 * SF_B + lt * 16) = R[9]; } while (0)
#define SEQ_STEP(R, s) do { if ((s) + 1 < 132) SEQ_STORE(R, ((s) + 1) & 1); SEQ_LOAD(R, (s) + 5); SEQ_BAR(); } while (0)
            SEQ_LOAD(ra, 0); SEQ_STORE(ra, 0);
            SEQ_LOAD(ra, 1); SEQ_LOAD(rb, 2); SEQ_LOAD(rc, 3); SEQ_LOAD(rd, 4);
            SEQ_BAR();
            for (int s = 0; s < 132; s += 4) { SEQ_STEP(ra, s); SEQ_STEP(rb, s + 1); SEQ_STEP(rc, s + 2); SEQ_STEP(rd, s + 3); }
#undef SEQ_LOAD
#undef SEQ_STORE
#undef SEQ_STEP
        } else if (wave < 2) {
            f32x4 S[8];
#pragma unroll
            for (int i = 0; i < 8; ++i) S[i] = (f32x4){0.f, 0.f, 0.f, 0.f};
            SEQ_BAR();
            for (int s = 0; s < 132; ++s) {
                const unsigned char* bb = shm + (s & 1) * BUF_B;
                bf16x8 ka[8][2], vb[2]; f32x4 el[8];
#pragma unroll
                for (int ts = 0; ts < 2; ++ts) { vb[ts] = *(const bf16x8*)(bb + QS_B + KS_B + (wave * 16 + l15) * 144 + ts * 64 + lg4 * 16);
#pragma unroll
                    for (int kt = 0; kt < 8; ++kt) ka[kt][ts] = *(const bf16x8*)(bb + QS_B + (kt * 16 + l15) * 144 + ts * 64 + lg4 * 16); }
#pragma unroll
                for (int kt = 0; kt < 8; ++kt) el[kt] = *(const f32x4*)(bb + QS_B + KS_B + VS_B + (kt * 16 + lg4 * 4) * 4);
#pragma unroll
                for (int kt = 0; kt < 8; ++kt) S[kt] = S[kt] * el[kt];
#pragma unroll
                for (int ts = 0; ts < 2; ++ts)
#pragma unroll
                    for (int kt = 0; kt < 8; ++kt) S[kt] = __builtin_amdgcn_mfma_f32_16x16x32_bf16(ka[kt][ts], vb[ts], S[kt], 0, 0, 0);
                unsigned char* sfp = shm + SF_OFF + ((s + 1) & 1) * SF_B + wave * 4096 + lane * 16;
#pragma unroll
                for (int ks = 0; ks < 4; ++ks) { u32x4 w; w.x = pk2(S[2 * ks][0], S[2 * ks][1]); w.y = pk2(S[2 * ks][2], S[2 * ks][3]);
                    w.z = pk2(S[2 * ks + 1][0], S[2 * ks + 1][1]); w.w = pk2(S[2 * ks + 1][2], S[2 * ks + 1][3]); *(u32x4*)(sfp + ks * 1024) = w; }
                SEQ_BAR();
            }
        } else {
            const int w2 = wave - 2;
            SEQ_BAR();
            for (int s = 0; s < 132; ++s) {
                const unsigned char* bb = shm + (s & 1) * BUF_B;
                const int cidx = SEQ_CIDX(s);
                const unsigned char* sfp = shm + SF_OFF + (s & 1) * SF_B + w2 * 4096 + lane * 16;
                bf16x8 sf[4]; u32x4 qf[4][4];
#pragma unroll
                for (int ks = 0; ks < 4; ++ks) sf[ks] = *(const bf16x8*)(sfp + ks * 1024);
#pragma unroll
                for (int tt = 0; tt < 4; ++tt)
#pragma unroll
                    for (int ks = 0; ks < 4; ++ks) qf[tt][ks] = *(const u32x4*)(bb + (tt * 16 + l15) * 288 + ks * 64 + lg4 * 16);
                f32x4 a4[4];
#pragma unroll
                for (int tt = 0; tt < 4; ++tt) a4[tt] = (f32x4){0.f, 0.f, 0.f, 0.f};
#pragma unroll
                for (int ks = 0; ks < 4; ++ks)
#pragma unroll
                    for (int tt = 0; tt < 4; ++tt) a4[tt] = __builtin_amdgcn_mfma_f32_16x16x32_bf16(sf[ks], __builtin_bit_cast(bf16x8, qf[tt][ks]), a4[tt], 0, 0, 0);
#pragma unroll
                for (int tt = 0; tt < 4; ++tt) { u32x2 w; w.x = pk2(a4[tt][0], a4[tt][1]); w.y = pk2(a4[tt][2], a4[tt][3]);
                    *(u32x2*)(OI + (size_t)(cidx * 64 + tt * 16 + l15) * D + h * 256 + vs * 32 + w2 * 16 + lg4 * 4) = w; }
                SEQ_BAR();
            }
        }
#undef SEQ_CIDX
    }
#undef SEQ_BAR
}

DI void phase_gla_combine(const Params& p, int row_lo, int row_hi, int wgi, int nwg) {
    const int wave = threadIdx.x >> 6, lane = threadIdx.x & 63;
    const u16* O0 = (const u16*)(p.ws + OFF_R0); const u16* O1 = (const u16*)(p.ws + OFF_R1); const u16* O2 = (const u16*)(p.ws + OFF_R2);
    const u16* G = (const u16*)(p.ws + OFF_R3); u16* A2 = (u16*)(p.ws + OFF_R4);
    const int vc = (lane & 31) * 8;
    const f32x4 gn0 = *(const f32x4*)(p.in[13] + vc), gn1 = *(const f32x4*)(p.in[13] + vc + 4);
    const float gn[8] = {gn0[0], gn0[1], gn0[2], gn0[3], gn1[0], gn1[1], gn1[2], gn1[3]};
    for (int row = row_lo + wgi * 16 + wave * 2; row < row_hi; row += nwg * 16) {
        u32x4 a[2][2], b[2][2], c[2][2], g[2][2];
#pragma unroll
        for (int r = 0; r < 2; ++r)
#pragma unroll
            for (int q = 0; q < 2; ++q) { const size_t o = (size_t)(row + r) * D + q * 512 + lane * 8;
                a[r][q] = ntload((const u32x4*)(O0 + o)); b[r][q] = ntload((const u32x4*)(O1 + o)); c[r][q] = ntload((const u32x4*)(O2 + o)); g[r][q] = ntload((const u32x4*)(G + o)); }
#pragma unroll
        for (int r = 0; r < 2; ++r)
#pragma unroll
            for (int q = 0; q < 2; ++q) {
                float v[8]; float ss = 0.f;
#pragma unroll
                for (int j = 0; j < 4; ++j) { v[2 * j] = lo_bf(a[r][q][j]) + lo_bf(b[r][q][j]) + lo_bf(c[r][q][j]); v[2 * j + 1] = hi_bf(a[r][q][j]) + hi_bf(b[r][q][j]) + hi_bf(c[r][q][j]); }
#pragma unroll
                for (int j = 0; j < 8; ++j) ss += v[j] * v[j];
                ss += __shfl_xor(ss, 1); ss += __shfl_xor(ss, 2); ss += __shfl_xor(ss, 4); ss += __shfl_xor(ss, 8); ss += __shfl_xor(ss, 16);
                const float rstd = rsqrtf(ss * (1.f / 256.f) + 1e-6f);
                u32x4 w;
#pragma unroll
                for (int j = 0; j < 4; ++j) { const float g0 = lo_bf(g[r][q][j]), g1 = hi_bf(g[r][q][j]);
                    w[j] = pk2(v[2 * j] * rstd * gn[2 * j] * silu_f(g0), v[2 * j + 1] * rstd * gn[2 * j + 1] * silu_f(g1)); }
                *(u32x4*)(A2 + (size_t)(row + r) * D + q * 512 + lane * 8) = w;
            }
    }
}

DI void phase_h1(const Params& p, int row_lo, int row_hi, int wgi, int nwg) {
    const int wave = threadIdx.x >> 6, lane = threadIdx.x & 63;
    const float* MOD = (const float*)(p.ws + OFF_MOD);
    const u16* Y = (const u16*)(p.ws + OFF_Y);
    u16* H = (u16*)(p.ws + OFF_R0);
    for (int row = row_lo + wgi * 16 + wave * 2; row < row_hi; row += nwg * 16) {
        const int vec = row < MX ? row >> 13 : 4;
        const float* mod0 = MOD + (size_t)vec * 3072; const float* mod1 = MOD + (size_t)(5 + vec) * 3072;
        f32x4 v[2][4]; u32x2 yy[2][4];
#pragma unroll
        for (int r = 0; r < 2; ++r) { const float* src = row_src(p, row + r);
#pragma unroll
            for (int i = 0; i < 4; ++i) { const int c = i * 256 + lane * 4; v[r][i] = ntload((const f32x4*)(src + c)); yy[r][i] = *(const u32x2*)(Y + (size_t)(row + r) * D + c); } }
        float rsy[2], rstd[2];
        f32x4 y[2][4];
#pragma unroll
        for (int r = 0; r < 2; ++r) { float ssy = 0.f;
#pragma unroll
            for (int i = 0; i < 4; ++i) { y[r][i] = (f32x4){lo_bf(yy[r][i].x), hi_bf(yy[r][i].x), lo_bf(yy[r][i].y), hi_bf(yy[r][i].y)};
                ssy += y[r][i][0] * y[r][i][0] + y[r][i][1] * y[r][i][1] + y[r][i][2] * y[r][i][2] + y[r][i][3] * y[r][i][3]; }
            rsy[r] = rsqrtf(wave_sum(ssy) * (1.f / 1024.f) + 1e-6f); }
        float ss[2] = {0.f, 0.f};
#pragma unroll
        for (int i = 0; i < 4; ++i) { const int c = i * 256 + lane * 4;
            const f32x4 np = *(const f32x4*)(p.in[7] + c), gt = *(const f32x4*)(mod0 + 2048 + c);
#pragma unroll
            for (int r = 0; r < 2; ++r)
#pragma unroll
                for (int j = 0; j < 4; ++j) { v[r][i][j] += gt[j] * (y[r][i][j] * rsy[r] * np[j]); ss[r] += v[r][i][j] * v[r][i][j]; } }
#pragma unroll
        for (int r = 0; r < 2; ++r) rstd[r] = rsqrtf(wave_sum(ss[r]) * (1.f / 1024.f) + 1e-6f);
#pragma unroll
        for (int i = 0; i < 4; ++i) { const int c = i * 256 + lane * 4;
            const f32x4 g = *(const f32x4*)(p.in[6] + 1024 + c), sh = *(const f32x4*)(mod1 + c), sc = *(const f32x4*)(mod1 + 1024 + c);
#pragma unroll
            for (int r = 0; r < 2; ++r) { float o[4];
#pragma unroll
                for (int j = 0; j < 4; ++j) o[j] = v[r][i][j] * rstd[r] * g[j] * (1.f + sc[j]) + sh[j];
                u32x2 w; w.x = pk2(o[0], o[1]); w.y = pk2(o[2], o[3]); *(u32x2*)(H + (size_t)row_perm(row + r) * D + c) = w; } }
    }
}

DI void phase_conv(const Params& p, float* outbuf) {
    const u16* Z = (const u16*)(p.ws + OFF_Z); u16* ZC = (u16*)outbuf;
    const float* cw = p.in[16]; const float* cb = p.in[17];
    const int total = (M / 8) * 160;
    for (int idx = blockIdx.x * 512 + threadIdx.x; idx < total; idx += gridDim.x * 512) {
        const int row0 = (idx / 160) * 8, ch = (idx % 160) * 8;
        const int pos0 = row0 < MX ? (row0 & 8191) : ((row0 - MX) & 255), len = row0 < MX ? 8192 : 256;
        u32x4 z[11];
#pragma unroll
        for (int i = 0; i < 11; ++i) { const int pp = pos0 + i - 2;
            z[i] = (pp >= 0 && pp < len) ? ntload((const u32x4*)(Z + (size_t)(row0 + i - 2) * LW + ch)) : (u32x4){0u, 0u, 0u, 0u}; }
        f32x4 w[4][2], bias[2];
#pragma unroll
        for (int j = 0; j < 4; ++j) { w[j][0] = *(const f32x4*)(cw + j * LW + ch); w[j][1] = *(const f32x4*)(cw + j * LW + ch + 4); }
        bias[0] = *(const f32x4*)(cb + ch); bias[1] = *(const f32x4*)(cb + ch + 4);
#pragma unroll
        for (int r = 0; r < 8; ++r) {
            f32x4 a0 = bias[0], a1 = bias[1];
#pragma unroll
            for (int j = 0; j < 4; ++j) { const u32x4 zz = z[r + j];
                a0[0] += w[j][0][0] * lo_bf(zz.x); a0[1] += w[j][0][1] * hi_bf(zz.x); a0[2] += w[j][0][2] * lo_bf(zz.y); a0[3] += w[j][0][3] * hi_bf(zz.y);
                a1[0] += w[j][1][0] * lo_bf(zz.z); a1[1] += w[j][1][1] * hi_bf(zz.z); a1[2] += w[j][1][2] * lo_bf(zz.w); a1[3] += w[j][1][3] * hi_bf(zz.w); }
            const u32x4 o = {pk2(a0[0], a0[1]), pk2(a0[2], a0[3]), pk2(a1[0], a1[1]), pk2(a1[2], a1[3])};
            *(u32x4*)(ZC + (size_t)(row0 + r) * LW + ch) = o;
        }
    }
}

DI void phase_lru_agg(const Params& p, const float* outbuf) {
    const unsigned* GAf = (const unsigned*)(p.ws + OFF_AU); const unsigned* GAb = GAf + (size_t)M * LW;
    const u16* ZC = (const u16*)outbuf;
    float* CA = (float*)(p.ws + OFF_CA); float* CU = (float*)(p.ws + OFF_CU);
    const int total = NCH * 320 * 2;
    for (int idx = blockIdx.x * 512 + threadIdx.x; idx < total; idx += gridDim.x * 512) {
        const int half = idx & 1, i2 = idx >> 1, c4 = i2 % 320, cidx = i2 / 320, ch = c4 * 4;
        const f32x4 baf = *(const f32x4*)(p.in[19] + ch), bxf = *(const f32x4*)(p.in[21] + ch), lf = *(const f32x4*)(p.in[22] + ch);
        const f32x4 bab = *(const f32x4*)(p.in[24] + ch), bxb = *(const f32x4*)(p.in[26] + ch), lb = *(const f32x4*)(p.in[27] + ch);
        f32x4 c8f, c8b;
#pragma unroll
        for (int j = 0; j < 4; ++j) { c8f[j] = 8.f * flog(1.f + fexp(-lf[j])); c8b[j] = 8.f * flog(1.f + fexp(-lb[j])); }
        const unsigned base = ((unsigned)cidx * 64u + half * 32u) * LW + ch;
        f32x4 Af = {1.f, 1.f, 1.f, 1.f}, Uf = {0.f, 0.f, 0.f, 0.f}, Pb = {1.f, 1.f, 1.f, 1.f}, Ub = {0.f, 0.f, 0.f, 0.f};
        u32x4 gfA[4], gbA[4], gfB[4], gbB[4]; u32x2 zcA[4], zcB[4];
#define AGG_LOAD(GF, GB, ZZ, tb) do { _Pragma("unroll") for (int q = 0; q < 4; ++q) { const unsigned o = base + (unsigned)((tb) * 4 + q) * LW; GF[q] = ntload((const u32x4*)(GAf + o)); GB[q] = ntload((const u32x4*)(GAb + o)); ZZ[q] = *(const u32x2*)(ZC + o); } } while (0)
#define AGG_COMP(GF, GB, ZZ) do { _Pragma("unroll") for (int q = 0; q < 4; ++q) { \
                const float z[4] = {lo_bf(ZZ[q].x), hi_bf(ZZ[q].x), lo_bf(ZZ[q].y), hi_bf(ZZ[q].y)}; \
                _Pragma("unroll") for (int j = 0; j < 4; ++j) { float a, u; \
                    gate_au(GF[q][j], z[j], baf[j], bxf[j], c8f[j], a, u); Uf[j] = a * Uf[j] + u; Af[j] *= a; \
                    gate_au(GB[q][j], z[j], bab[j], bxb[j], c8b[j], a, u); Ub[j] += Pb[j] * u; Pb[j] *= a; } } } while (0)
        AGG_LOAD(gfA, gbA, zcA, 0);
        for (int tb = 0; tb < 8; tb += 2) {
            AGG_LOAD(gfB, gbB, zcB, tb + 1);
            AGG_COMP(gfA, gbA, zcA);
            if (tb + 2 < 8) AGG_LOAD(gfA, gbA, zcA, tb + 2);
            AGG_COMP(gfB, gbB, zcB);
        }
#undef AGG_LOAD
#undef AGG_COMP
        f32x4 Af1, Uf1, Pb1, Ub1;
#pragma unroll
        for (int j = 0; j < 4; ++j) { Af1[j] = __shfl_xor(Af[j], 1); Uf1[j] = __shfl_xor(Uf[j], 1); Pb1[j] = __shfl_xor(Pb[j], 1); Ub1[j] = __shfl_xor(Ub[j], 1); }
        if (half == 0) {
            f32x4 A, U, P, UB;
#pragma unroll
            for (int j = 0; j < 4; ++j) { A[j] = Af[j] * Af1[j]; U[j] = Af1[j] * Uf[j] + Uf1[j]; P[j] = Pb[j] * Pb1[j]; UB[j] = Ub[j] + Pb[j] * Ub1[j]; }
            const size_t o = (size_t)cidx * LW + ch;
            *(f32x4*)(CA + o) = A; *(f32x4*)(CU + o) = U; *(f32x4*)(CA + (size_t)NCH * LW + o) = P; *(f32x4*)(CU + (size_t)NCH * LW + o) = UB;
        }
    }
}
DI void phase_lru_carry(const Params& p) {
    const float* CA = (const float*)(p.ws + OFF_CA); const float* CU = (const float*)(p.ws + OFF_CU); float* HS = (float*)(p.ws + OFF_HS);
    for (int idx = blockIdx.x * 512 + threadIdx.x; idx < 4 * 2 * LW; idx += gridDim.x * 512) {
        const int ch = idx % LW, dir = (idx / LW) & 1, b = idx / (2 * LW);
        float h = 0.f;
        for (int s0 = 0; s0 < 132; s0 += 12) {
            size_t o[12]; float a[12], u[12];
#pragma unroll
            for (int q = 0; q < 12; ++q) { const int s = s0 + q; const int cidx = s < 4 ? 512 + 4 * b + (dir ? 3 - s : s) : 128 * b + (dir ? 127 - (s - 4) : (s - 4));
                o[q] = ((size_t)dir * NCH + cidx) * LW + ch; a[q] = CA[o[q]]; u[q] = CU[o[q]]; }
#pragma unroll
            for (int q = 0; q < 12; ++q) { HS[o[q]] = h; h = a[q] * h + u[q]; }
        }
    }
}
DI void phase_lru_apply(const Params& p, unsigned char* shm, float* outbuf) {
    const int tid = threadIdx.x;
    float* hf = (float*)shm;
    const unsigned* GAf = (const unsigned*)(p.ws + OFF_AU); const unsigned* GAb = GAf + (size_t)M * LW;
    const float* HS = (const float*)(p.ws + OFF_HS);
    const u16* G2 = (const u16*)(p.ws + OFF_G2); u16* ZA = (u16*)outbuf;
    for (int wi = blockIdx.x; wi < 1280; wi += gridDim.x) {
        const int item = wi * 2 + (tid >> 8), cidx = item / 5, ch = (item % 5) * 256 + (tid & 255);
        const unsigned base = (unsigned)cidx * 64u * LW + ch;
        const float baf = p.in[19][ch], bxf = p.in[21][ch], c8f = 8.f * flog(1.f + fexp(-p.in[22][ch]));
        const float bab = p.in[24][ch], bxb = p.in[26][ch], c8b = 8.f * flog(1.f + fexp(-p.in[27][ch]));
        float h = HS[(size_t)cidx * LW + ch];
        const float hb0 = HS[((size_t)NCH + cidx) * LW + ch];
        for (int tb = 0; tb < 2; ++tb) {
            unsigned w[32]; u16 z[32];
#pragma unroll
            for (int q = 0; q < 32; ++q) { const unsigned o = base + (unsigned)(tb * 32 + q) * LW; w[q] = ntload(GAf + o); z[q] = ZA[o]; }
#pragma unroll
            for (int q = 0; q < 32; ++q) { float a, u; gate_au(w[q], bf2f(z[q]), baf, bxf, c8f, a, u); h = a * h + u; hf[(tb * 32 + q) * 512 + tid] = h; }
        }
        h = hb0;
        for (int tb = 3; tb >= 0; --tb) {
            unsigned w[16]; u16 z[16], g[16];
#pragma unroll
            for (int q = 0; q < 16; ++q) { const unsigned o = base + (unsigned)(tb * 16 + q) * LW; w[q] = ntload(GAb + o); z[q] = ntload(ZA + o); g[q] = ntload(G2 + o); }
#pragma unroll
            for (int q = 15; q >= 0; --q) { float a, u; gate_au(w[q], bf2f(z[q]), bab, bxb, c8b, a, u); h = a * h + u;
                const float tot = hf[(tb * 16 + q) * 512 + tid] + h;
                ZA[base + (unsigned)(tb * 16 + q) * LW] = f2bf(tot * silu_f(bf2f(g[q]))); }
        }
    }
}

DI void phase_final(const Params& p) {
    const int wave = threadIdx.x >> 6, lane = threadIdx.x & 63;
    const float* MOD = (const float*)(p.ws + OFF_MOD);
    const u16* Y = (const u16*)(p.ws + OFF_Y); const u16* Y2 = (const u16*)(p.ws + OFF_Y2);
    for (int row = blockIdx.x * 16 + wave * 2; row < MX; row += gridDim.x * 16) {
        const int vec = row >> 13;
        const float* gt0 = MOD + (size_t)vec * 3072 + 2048; const float* gt1 = MOD + (size_t)(5 + vec) * 3072 + 2048;
        f32x4 v[2][4]; u32x2 yy[2][4], zz[2][4];
#pragma unroll
        for (int r = 0; r < 2; ++r) { const float* src = p.in[0] + (size_t)(row + r) * D; const size_t prow = (size_t)row_perm(row + r);
#pragma unroll
            for (int i = 0; i < 4; ++i) { const int c = i * 256 + lane * 4; v[r][i] = ntload((const f32x4*)(src + c));
                yy[r][i] = ntload((const u32x2*)(Y + (size_t)(row + r) * D + c)); zz[r][i] = ntload((const u32x2*)(Y2 + prow * D + c)); } }
        f32x4 y[2][4], y2[2][4]; float rsy[2], rs2[2];
#pragma unroll
        for (int r = 0; r < 2; ++r) { float ssy = 0.f, ss2 = 0.f;
#pragma unroll
            for (int i = 0; i < 4; ++i) { y[r][i] = (f32x4){lo_bf(yy[r][i].x), hi_bf(yy[r][i].x), lo_bf(yy[r][i].y), hi_bf(yy[r][i].y)};
                y2[r][i] = (f32x4){lo_bf(zz[r][i].x), hi_bf(zz[r][i].x), lo_bf(zz[r][i].y), hi_bf(zz[r][i].y)};
#pragma unroll
                for (int j = 0; j < 4; ++j) { ssy += y[r][i][j] * y[r][i][j]; ss2 += y2[r][i][j] * y2[r][i][j]; } }
            rsy[r] = rsqrtf(wave_sum(ssy) * (1.f / 1024.f) + 1e-6f); rs2[r] = rsqrtf(wave_sum(ss2) * (1.f / 1024.f) + 1e-6f); }
#pragma unroll
        for (int i = 0; i < 4; ++i) { const int c = i * 256 + lane * 4;
            const f32x4 np0 = *(const f32x4*)(p.in[7] + c), np1 = *(const f32x4*)(p.in[7] + 1024 + c), g0 = *(const f32x4*)(gt0 + c), g1 = *(const f32x4*)(gt1 + c);
#pragma unroll
            for (int r = 0; r < 2; ++r) { f32x4 o;
#pragma unroll
                for (int j = 0; j < 4; ++j) { const float x1 = v[r][i][j] + g0[j] * (y[r][i][j] * rsy[r] * np0[j]); o[j] = x1 + g1[j] * (y2[r][i][j] * rs2[r] * np1[j]); }
                ntstore(o, (f32x4*)(p.out + (size_t)(row + r) * D + c)); } }
    }
}


#define XB_TMO      128
#define XB_XCNT(j)  (256  + 64 * (j))
#define XB_XSUB(j)  (1280 + 64 * (j))
#define XB_XGEN(j)  (2304 + 64 * (j))
#define XB_TOP      3328
#define XB_TOPGEN   3392
#define XCD_BAR_WORDS 3456
#define XB_SPIN_CAP (1u << 18)
DI unsigned xb_ld(unsigned* p)              { return __hip_atomic_load(p, __ATOMIC_RELAXED, __HIP_MEMORY_SCOPE_AGENT); }
DI unsigned xb_add(unsigned* p, unsigned v) { return __hip_atomic_fetch_add(p, v, __ATOMIC_RELAXED, __HIP_MEMORY_SCOPE_AGENT); }
DI unsigned xb_xcc_id() { return (unsigned)__builtin_amdgcn_s_getreg((3 << 11) | 20) & 0xFu; }
#define XB_SPIN(cond, bar) do { unsigned _sp = 0; while (cond) { __builtin_amdgcn_s_sleep(1); \
    if ((++_sp & 255u) == 0u) { if (xb_ld(&(bar)[XB_TMO])) break; if (_sp > XB_SPIN_CAP) { atomicAdd(&(bar)[XB_TMO], 1u); break; } } } } while (0)
struct XcdBarrier { unsigned* bar; unsigned x; volatile LAS unsigned* st; };
DI XcdBarrier xcd_barrier_post(unsigned* bar, volatile LAS unsigned* st) {
    XcdBarrier b; b.bar = bar; b.x = xb_xcc_id(); b.st = st;
    if (threadIdx.x == 0) (void)xb_add(&bar[XB_XCNT(b.x)], 1u);
    return b;
}
DI void xcd_barrier_complete(unsigned* bar, unsigned x, unsigned& nloc, unsigned& nx) {
    const unsigned G = gridDim.x * gridDim.y * gridDim.z;
    unsigned sum, cnt, mine, sp = 0u;
    for (;;) {
        sum = 0u; cnt = 0u; mine = 0u;
#pragma unroll
        for (unsigned j = 0; j < 16; ++j) { const unsigned c = xb_ld(&bar[XB_XCNT(j)]); sum += c; cnt += (c > 0u) ? 1u : 0u; mine = (j == x) ? c : mine; }
        if (sum == G) break;
        __builtin_amdgcn_s_sleep(1);
        if ((++sp & 255u) == 0u) { if (xb_ld(&bar[XB_TMO])) break; if (sp > XB_SPIN_CAP) { atomicAdd(&bar[XB_TMO], 1u); break; } }
    }
    nloc = mine > 0u ? mine : 1u; nx = cnt > 0u ? cnt : 1u;
}
DI void xcd_barrier(const XcdBarrier& b) {
    asm volatile("s_waitcnt vmcnt(0)" ::: "memory");
    __syncthreads();
    if (threadIdx.x == 0) {
        unsigned* bar = b.bar;
        __builtin_amdgcn_s_waitcnt(0);
        unsigned nloc = b.st[0], nx = b.st[1];
        if (nloc == 0u) { xcd_barrier_complete(bar, b.x, nloc, nx); b.st[0] = nloc; b.st[1] = nx; }
        const unsigned old = xb_add(&bar[XB_XSUB(b.x)], 1u);
        const unsigned gen = old / nloc;
        if (old + 1u == (gen + 1u) * nloc) {
            __builtin_amdgcn_fence(__ATOMIC_RELEASE, "agent");
            asm volatile("s_waitcnt vmcnt(0)" ::: "memory");
            const unsigned og = xb_add(&bar[XB_TOP], 1u);
            const unsigned tg = og / nx;
            if (og + 1u == (tg + 1u) * nx) xb_add(&bar[XB_TOPGEN], 1u);
            else XB_SPIN(xb_ld(&bar[XB_TOPGEN]) == tg, bar);
            __builtin_amdgcn_fence(__ATOMIC_ACQUIRE, "agent");
            xb_add(&bar[XB_XGEN(b.x)], 1u);
            asm volatile("s_waitcnt vmcnt(0)" ::: "memory");
        } else {
            XB_SPIN(xb_ld(&bar[XB_XGEN(b.x)]) == gen, bar);
            __builtin_amdgcn_fence(__ATOMIC_ACQUIRE, "agent");
            asm volatile("s_waitcnt vmcnt(0)" ::: "memory");
        }
    }
    __syncthreads();
}

constexpr int NPHASE = 18;
__global__ void __launch_bounds__(512, 2) fwd_megakernel(Params p, int ph0, int ph1) {
    extern __shared__ __attribute__((aligned(16))) unsigned char shm[];
    __shared__ __attribute__((aligned(16))) unsigned xb_words[4];
    LAS unsigned char* lds = (LAS unsigned char*)shm;
    cg::grid_group grid = cg::this_grid();
    XcdBarrier xb; xb.bar = (unsigned*)(p.ws + OFF_BAR); xb.x = 0; xb.st = (volatile LAS unsigned*)xb_words;
    if (ph1 - ph0 > 1) { if (threadIdx.x < 4) xb_words[threadIdx.x] = 0u; __syncthreads(); xb = xcd_barrier_post((unsigned*)(p.ws + OFF_BAR), (volatile LAS unsigned*)xb_words); }
    pg8::StaticOrder S;
#define PHASE(k) if (((PH_MASK >> (k)) & 1) && ph0 <= (k) && (k) < ph1)
#define SYNC(k) if (ph0 <= (k) && (k) + 1 < ph1) { if (ph1 > NPHASE) grid.sync(); else xcd_barrier(xb); }
    PHASE(0) { phase_prep(p, shm); } SYNC(0);
    PHASE(1) {
        if (blockIdx.x < 64 && gridDim.x > 64) phase_transposes(p, shm, blockIdx.x, 64);
        else if (gridDim.x > 64) phase_h0(p, blockIdx.x - 64, gridDim.x - 64);
        else { phase_transposes(p, shm, blockIdx.x, gridDim.x); phase_h0(p, blockIdx.x, gridDim.x); }
    } SYNC(1);
    PHASE(2) {
        pg8::Gemm g = {(const u16*)(p.ws + OFF_R0), (const u16*)(p.ws + OFF_WT1), M, 3328, 1024, 1024, 1024, 0, 0};
        EpiBf16Split E; E.base[0] = (u16*)(p.ws + OFF_R1); E.base[1] = (u16*)(p.ws + OFF_R2); E.base[2] = (u16*)(p.ws + OFF_R3); E.split_tiles = 4; E.ldc = 1024; E.lr = (float*)(p.ws + OFF_LR); E.lr_tile = 12;
        S.init(g.M, g.N, gridDim.x, blockIdx.x); pg8::gemm_phase(lds, g, S, E);
    } SYNC(2);
    PHASE(3) { phase_gla_chunk(p, shm, p.out); } SYNC(3);
    PHASE(4) { phase_gla_seq<0>(p, shm, p.out); } SYNC(4);
    PHASE(5) { phase_gla_combine(p, MX, M, blockIdx.x, gridDim.x); } SYNC(5);
    PHASE(6) {
        if (blockIdx.x < 16) {
            pg8::Gemm g = {(const u16*)(p.ws + OFF_R4) + (size_t)MX * 1024, (const u16*)(p.ws + OFF_WT2), MC, 1024, 1024, 1024, 1024, 0, 0};
            EpiBf16Split E; E.base[0] = E.base[1] = E.base[2] = (u16*)(p.ws + OFF_Y); E.split_tiles = 64; E.ldc = 1024; E.lr = nullptr; E.lr_tile = -1; E.row_base = MX;
            S.init(g.M, g.N, 16, blockIdx.x); pg8::gemm_phase(lds, g, S, E);
        } else phase_gla_combine(p, 0, MX, blockIdx.x - 16, gridDim.x - 16);
    } SYNC(6);
    PHASE(7) {
        pg8::Gemm g = {(const u16*)(p.ws + OFF_R4), (const u16*)(p.ws + OFF_WT2), MX, 1024, 1024, 1024, 1024, 0, 0};
        EpiBf16Split E; E.base[0] = E.base[1] = E.base[2] = (u16*)(p.ws + OFF_Y); E.split_tiles = 64; E.ldc = 1024; E.lr = nullptr; E.lr_tile = -1;
        S.init(g.M, g.N, gridDim.x, blockIdx.x); pg8::gemm_phase(lds, g, S, E);
    } SYNC(7);
    PHASE(8) { phase_h1(p, MX, M, blockIdx.x, gridDim.x); } SYNC(8);
    PHASE(9) {
        if (blockIdx.x < 40) {
            pg8::Gemm g = {(const u16*)(p.ws + OFF_R0) + (size_t)MX * 1024, (const u16*)(p.ws + OFF_WT3), MC, 2560, 1024, 1024, 1024, 0, 0};
            EpiBf16Split E; E.base[0] = (u16*)(p.ws + OFF_Z); E.base[1] = E.base[2] = (u16*)(p.ws + OFF_G2); E.split_tiles = 5; E.ldc = 1280; E.lr = nullptr; E.lr_tile = -1; E.row_base = MX;
            S.init(g.M, g.N, 40, blockIdx.x); pg8::gemm_phase(lds, g, S, E);
        } else phase_h1(p, 0, MX, blockIdx.x - 40, gridDim.x - 40);
    } SYNC(9);
    PHASE(10) {
        pg8::Gemm g = {(const u16*)(p.ws + OFF_R0), (const u16*)(p.ws + OFF_WT3), MX, 2560, 1024, 1024, 1024, 0, 0};
        EpiBf16Split E; E.base[0] = (u16*)(p.ws + OFF_Z); E.base[1] = E.base[2] = (u16*)(p.ws + OFF_G2); E.split_tiles = 5; E.ldc = 1280; E.lr = nullptr; E.lr_tile = -1;
        S.init(g.M, g.N, gridDim.x, blockIdx.x); pg8::gemm_phase(lds, g, S, E);
    } SYNC(10);
    PHASE(11) { phase_conv(p, p.out); } SYNC(11);
    PHASE(12) {
        pg8::Gemm g = {(const u16*)p.out, (const u16*)(p.ws + OFF_WT4), M, 5120, 256, 1280, 256, 2, 512};
        EpiPair E; E.GA = (unsigned*)(p.ws + OFF_AU);
        S.init(g.M, g.N, gridDim.x, blockIdx.x); pg8::gemm_phase(lds, g, S, E);
    } SYNC(12);
    PHASE(13) { phase_lru_agg(p, p.out); } SYNC(13);
    PHASE(14) { phase_lru_carry(p); } SYNC(14);
    PHASE(15) { phase_lru_apply(p, shm, p.out); } SYNC(15);
    PHASE(16) {
        pg8::Gemm g = {(const u16*)p.out, (const u16*)(p.ws + OFF_WT5), MX, 1024, 1280, 1280, 1280, 0, 0};
        EpiBf16Split E; E.base[0] = E.base[1] = E.base[2] = (u16*)(p.ws + OFF_Y2); E.split_tiles = 64; E.ldc = 1024; E.lr = nullptr; E.lr_tile = -1;
        S.init(g.M, g.N, gridDim.x, blockIdx.x); pg8::gemm_phase(lds, g, S, E);
    } SYNC(16);
    PHASE(17) { phase_final(p); }
#undef PHASE
#undef SYNC
}

extern "C" void kernel_launch(void* const* d_in, const int* in_sizes, int n_in, void* d_out, int out_size, void* d_ws, size_t ws_size, hipStream_t stream) {
    constexpr size_t kDynLds = 131072;
    static int grid_blocks = 0;
    if (!grid_blocks) {
        hipFuncSetAttribute((const void*)fwd_megakernel, hipFuncAttributeMaxDynamicSharedMemorySize, (int)kDynLds);
        int dev = 0, cus = 0, per_cu = 0;
        hipGetDevice(&dev);
        hipDeviceGetAttribute(&cus, hipDeviceAttributeMultiprocessorCount, dev);
        hipOccupancyMaxActiveBlocksPerMultiprocessor(&per_cu, fwd_megakernel, 512, kDynLds);
        if (per_cu < 1) per_cu = 1;
        grid_blocks = cus * 1;
    }
    Params p{};
    for (int i = 0; i < 29; ++i) p.in[i] = (const float*)d_in[i];
    p.out = (float*)d_out; p.ws = (unsigned char*)d_ws;
#if MULTI_LAUNCH
    for (int k = 0; k < NPHASE; ++k) for (int rep = 0; rep <= ((REP_MASK >> k) & 1); ++rep) fwd_megakernel<<<dim3(grid_blocks), dim3(512), kDynLds, stream>>>(p, k, k + 1);
#else
    int ph0 = 0, ph1 = NPHASE;
    (void)hipMemsetAsync((unsigned char*)d_ws + OFF_BAR, 0, XCD_BAR_WORDS * sizeof(unsigned), stream);
    void* args[] = {&p, &ph0, &ph1};
    hipError_t e = hipLaunchCooperativeKernel((void*)fwd_megakernel, dim3(grid_blocks), dim3(512), args, kDynLds, stream);
    if (e != hipSuccess) fprintf(stderr, "cooperative launch failed: %s (grid %d)\n", hipGetErrorString(e), grid_blocks);
#endif
}
```

```cpp
#include <hip/hip_runtime.h>
#include <hip/hip_cooperative_groups.h>
#include <cstdio>
namespace cg = cooperative_groups;

#ifndef PH_MASK
#define PH_MASK 0xFFFFFF
#endif
#ifndef REP_MASK
#define REP_MASK 0
#endif
#ifndef EXTRA
#define EXTRA 0
#endif
#ifndef MULTI_LAUNCH
#define MULTI_LAUNCH 0
#endif

typedef unsigned short u16;
typedef short bf16x8 __attribute__((ext_vector_type(8)));
typedef float f32x4 __attribute__((ext_vector_type(4)));
typedef float f32x2 __attribute__((ext_vector_type(2)));
typedef unsigned u32x4 __attribute__((ext_vector_type(4)));
typedef unsigned u32x2 __attribute__((ext_vector_type(2)));
typedef __bf16 bfv2 __attribute__((ext_vector_type(2)));
#define LAS __attribute__((address_space(3)))
#define DI __device__ __forceinline__

constexpr int D = 1024, MX = 32768, MC = 1024, M = MX + MC;
constexpr int NCH = M / 64;
constexpr int LW = 1280;
constexpr size_t MiB = 1024 * 1024;
constexpr size_t OFF_Y = 0;
constexpr size_t OFF_R0 = 66 * MiB;
constexpr size_t OFF_R1 = 132 * MiB;
constexpr size_t OFF_R2 = 198 * MiB;
constexpr size_t OFF_R3 = 264 * MiB;
constexpr size_t OFF_R4 = 330 * MiB;
constexpr size_t OFF_VT = 396 * MiB;
constexpr size_t OFF_WT1 = 462 * MiB;
constexpr size_t OFF_WT2 = OFF_WT1 + 7 * MiB;
constexpr size_t OFF_LR = OFF_WT2 + 2 * MiB;
constexpr size_t OFF_EL = OFF_LR + 5 * MiB;
constexpr size_t OFF_MOD = 479 * MiB;
constexpr size_t OFF_WT3 = OFF_MOD + 1 * MiB;
constexpr size_t OFF_WT4 = OFF_WT3 + 5 * MiB;
constexpr size_t OFF_WT5 = OFF_WT4 + 3 * MiB;
constexpr size_t OFF_CA = OFF_WT5 + 3 * MiB;
constexpr size_t OFF_CU = OFF_CA + 6 * MiB;
constexpr size_t OFF_HS = OFF_CU + 6 * MiB;
constexpr size_t OFF_BAR = OFF_HS + 6 * MiB;
constexpr size_t OFF_AU = 66 * MiB;
constexpr size_t OFF_Z = 132 * MiB;
constexpr size_t OFF_G2 = 396 * MiB;
constexpr size_t OFF_Y2 = 66 * MiB;

struct Params {
    const float* in[29];
    float* out;
    unsigned char* ws;
};

template <class T> DI T ntload(const T* p) { return __builtin_nontemporal_load(p); }
template <class T> DI void ntstore(T v, T* p) { __builtin_nontemporal_store(v, p); }
DI float bf2f(u16 b) { return __uint_as_float(((unsigned)b) << 16); }
DI unsigned pk2(float lo, float hi) { f32x2 v = {lo, hi}; bfv2 b = __builtin_convertvector(v, bfv2); return __builtin_bit_cast(unsigned, b); }
DI u16 f2bf(float f) { return (u16)(pk2(f, 0.f) & 0xffffu); }
DI float lo_bf(unsigned w) { return __uint_as_float(w << 16); }
DI float hi_bf(unsigned w) { return __uint_as_float(w & 0xffff0000u); }
DI float wave_sum(float v) {
#pragma unroll
    for (int o = 32; o; o >>= 1) v += __shfl_xor(v, o);
    return v;
}
DI float fexp(float x) { return __builtin_amdgcn_exp2f(x * 1.4426950408889634f); }
DI float flog(float x) { return __builtin_amdgcn_logf(x) * 0.6931471805599453f; }
DI float sigmoid_f(float x) { return __builtin_amdgcn_rcpf(1.f + fexp(-x)); }
DI float silu_f(float x) { return x * sigmoid_f(x); }

namespace pg8 {
constexpr int BM = 256, BK = 64, HALF = 128, HTB = HALF * BK * 2, STAGE_BYTES = 8 * HTB, NXCD = 8, WGM = 8;
DI int lds_byte(int r, int c) { const int st = (r >> 4) * 2 + (c >> 5), rr = r & 15, cc = c & 31, ob = rr * 64 + cc * 2; return st * 1024 + (ob ^ (((ob >> 9) & 1) << 5)); }
DI void stage_rc(int b, int& R, int& C) { const int st = b / 1024, sb = b % 1024, swz = sb ^ (((sb >> 9) & 1) << 5); R = (st >> 1) * 16 + swz / 64; C = (st & 1) * 32 + (swz % 64) / 2; }
DI int perm32(int rho) { const int n = rho >> 4, i = rho & 15; return 8 * (i >> 2) + 4 * n + (i & 3); }
struct Unit { int pm, pn; };
struct Gemm { const u16* A; const u16* Bt; int M, N, K, lda, ldb, a_shift, a_colbytes; };
struct StaticOrder {
    int nM, nN, nwg, G, c;
    DI void init(int M_, int N_, int G_, int c_) { nM = M_ / BM; nN = N_ / BM; nwg = nM * nN; G = G_; c = c_; }
    DI bool next(int i, Unit& u) const {
        const long L = (long)i * G + c; if (L >= nwg) return false;
        int wgid = (int)L; { const int q = nwg / NXCD, r = nwg % NXCD, xcd = wgid % NXCD, off = wgid / NXCD; wgid = (xcd < r ? xcd * (q + 1) : r * (q + 1) + (xcd - r) * q) + off; }
        const int nig = WGM * nN, gid = wgid / nig, fm = gid * WGM, gsz = (nM - fm) < WGM ? (nM - fm) : WGM;
        u.pm = fm + ((wgid % nig) % gsz); u.pn = (wgid % nig) / gsz; return true;
    }
};

template <class Epi>
DI void gemm_phase(LAS unsigned char* lds, const Gemm g, const StaticOrder& S, const Epi& E) {
    const int tid = threadIdx.x, wid = __builtin_amdgcn_readfirstlane(tid >> 6), lane = tid & 63, wr = wid >> 2, wc = wid & 3, fr = lane & 15, fq = lane >> 4;
    const int K = g.K, nt = K / BK;
    unsigned voffA[2], voffB[2];
#pragma unroll
    for (int i = 0; i < 2; ++i) { int R, C; stage_rc(tid * 16 + i * 8192, R, C); const int Rb = Epi::PERM ? ((R & ~31) + perm32(R & 31)) : R;
        voffA[i] = (unsigned)(R * g.lda + C) * 2u; voffB[i] = (unsigned)(Rb * g.ldb + C) * 2u; }
    const size_t kstep = (size_t)(BK * 2);
    const size_t hstepA = (size_t)HALF * g.lda * 2, hstepB = (size_t)HALF * g.ldb * 2;
    const unsigned ldsw = (unsigned)wid * 1024u;
    const int aoff = lds_byte(wr * 64 + fr, fq * 8), boff = lds_byte(wc * 32 + fr, fq * 8);
#define PG8_SA(b, h) (((b) * 2 + (h)) * HTB)
#define PG8_SB(b, h) ((4 + (b) * 2 + (h)) * HTB)
#define PG8_STAGE(bufoff, gbase, voff) do { _Pragma("unroll") for (int _i = 0; _i < 2; ++_i) \
        __builtin_amdgcn_global_load_lds((const unsigned*)((const char*)(gbase) + (voff)[_i]), (LAS unsigned*)(lds + (bufoff) + ldsw + _i * 8192), 16, 0, 0); } while (0)
#define PG8_LDA(dst, b, h) do { _Pragma("unroll") for (int m = 0; m < 4; ++m) _Pragma("unroll") for (int k = 0; k < 2; ++k) dst[m][k] = *(const LAS bf16x8*)(lds + PG8_SA(b, h) + aoff + m * 2048 + k * 1024); } while (0)
#define PG8_LDB(dst, b, h) do { _Pragma("unroll") for (int n = 0; n < 2; ++n) _Pragma("unroll") for (int k = 0; k < 2; ++k) dst[n][k] = *(const LAS bf16x8*)(lds + PG8_SB(b, h) + boff + n * 2048 + k * 1024); } while (0)
#define PG8_MMA(ai, bj, At, Bt) do { __builtin_amdgcn_s_setprio(1); _Pragma("unroll") for (int m = 0; m < 4; ++m) _Pragma("unroll") for (int n = 0; n < 2; ++n) _Pragma("unroll") for (int k = 0; k < 2; ++k) \
        acc[ai][bj][m][n] = __builtin_amdgcn_mfma_f32_16x16x32_bf16(Bt[n][k], At[m][k], acc[ai][bj][m][n], 0, 0, 0); __builtin_amdgcn_s_setprio(0); } while (0)
#define PG8_WAIT_V(n) asm volatile("s_waitcnt vmcnt(" #n ")" ::: "memory")
#define PG8_WAIT_L(n) asm volatile("s_waitcnt lgkmcnt(" #n ")" ::: "memory")
#define PG8_BAR __builtin_amdgcn_s_barrier()
#define PG8_SCHED __builtin_amdgcn_sched_barrier(0)
#define PG8_APTR(u) ((const char*)g.A + (size_t)(u).pm * 2 * hstepA + (size_t)((u).pn >> g.a_shift) * g.a_colbytes)
#define PG8_BPTR(u) ((const char*)g.Bt + (size_t)(u).pn * 2 * hstepB)
    Unit cur, nxt; int ui = 0;
    if (!S.next(0, cur)) return;
    f32x4 acc[2][2][4][2];
#pragma unroll
    for (int a = 0; a < 2; ++a)
#pragma unroll
        for (int b = 0; b < 2; ++b)
#pragma unroll
            for (int m = 0; m < 4; ++m)
#pragma unroll
                for (int n = 0; n < 2; ++n) acc[a][b][m][n] = (f32x4){0.f, 0.f, 0.f, 0.f};
    bf16x8 At[4][2], B0[2][2], B1[2][2];
    const char* cA = PG8_APTR(cur); const char* cB = PG8_BPTR(cur);
    PG8_STAGE(PG8_SB(0, 0), cB, voffB); PG8_STAGE(PG8_SA(0, 0), cA, voffA); PG8_STAGE(PG8_SB(0, 1), cB + hstepB, voffB); PG8_STAGE(PG8_SA(0, 1), cA + hstepA, voffA);
    if (wr == 1) PG8_BAR;
    PG8_WAIT_V(4); PG8_BAR;
    PG8_STAGE(PG8_SB(1, 0), cB + kstep, voffB); PG8_STAGE(PG8_SA(1, 0), cA + kstep, voffA); PG8_STAGE(PG8_SB(1, 1), cB + hstepB + kstep, voffB);
    PG8_WAIT_V(6); PG8_BAR;
    for (;;) {
        const bool has_next = S.next(ui + 1, nxt);
        const char* nA = has_next ? PG8_APTR(nxt) : cA; const char* nB = has_next ? PG8_BPTR(nxt) : cB;
        for (int t = 0; t < nt; t += 2) {
            const bool last = (t == nt - 2);
            const char* a1 = cA + (size_t)(t + 1) * kstep;
            const char* a2 = last ? nA : cA + (size_t)(t + 2) * kstep; const char* b2 = last ? nB : cB + (size_t)(t + 2) * kstep;
            const char* a3 = a2 + kstep; const char* b3 = b2 + kstep;
            PG8_LDB(B0, 0, 0); PG8_SCHED; PG8_LDA(At, 0, 0); PG8_STAGE(PG8_SA(1, 1), a1 + hstepA, voffA);
            PG8_WAIT_L(8); PG8_BAR; PG8_WAIT_L(0); PG8_MMA(0, 0, At, B0); PG8_BAR; PG8_SCHED;
            PG8_LDB(B1, 0, 1); PG8_STAGE(PG8_SB(0, 0), b2, voffB);
            PG8_BAR; PG8_WAIT_L(0); PG8_MMA(0, 1, At, B1); PG8_BAR;
            PG8_LDA(At, 0, 1); PG8_STAGE(PG8_SA(0, 0), a2, voffA);
            PG8_BAR; PG8_WAIT_L(0); PG8_MMA(1, 0, At, B0); PG8_BAR; PG8_SCHED;
            PG8_STAGE(PG8_SB(0, 1), b2 + hstepB, voffB);
            PG8_WAIT_V(6); PG8_BAR; PG8_MMA(1, 1, At, B1); PG8_BAR;
            PG8_LDB(B0, 1, 0); PG8_SCHED; PG8_LDA(At, 1, 0); PG8_STAGE(PG8_SA(0, 1), a2 + hstepA, voffA);
            PG8_WAIT_L(8); PG8_BAR; PG8_WAIT_L(0); PG8_MMA(0, 0, At, B0); PG8_BAR; PG8_SCHED;
            PG8_LDB(B1, 1, 1); PG8_STAGE(PG8_SB(1, 0), b3, voffB);
            PG8_BAR; PG8_WAIT_L(0); PG8_MMA(0, 1, At, B1); PG8_BAR;
            PG8_LDA(At, 1, 1); PG8_STAGE(PG8_SA(1, 0), a3, voffA);
            PG8_BAR; PG8_WAIT_L(0); PG8_MMA(1, 0, At, B0); PG8_BAR; PG8_SCHED;
            PG8_STAGE(PG8_SB(1, 1), b3 + hstepB, voffB);
            PG8_WAIT_V(6); PG8_BAR; PG8_MMA(1, 1, At, B1); PG8_BAR;
        }
        E(acc, cur, wr, wc, fr, fq);
        if (!has_next) break;
#pragma unroll
        for (int a = 0; a < 2; ++a)
#pragma unroll
            for (int b = 0; b < 2; ++b)
#pragma unroll
                for (int m = 0; m < 4; ++m)
#pragma unroll
                    for (int n = 0; n < 2; ++n) acc[a][b][m][n] = (f32x4){0.f, 0.f, 0.f, 0.f};
        cur = nxt; cA = nA; cB = nB; ++ui;
    }
    PG8_WAIT_V(0);
    if (wr == 0) PG8_BAR;
    PG8_BAR;
#undef PG8_SA
#undef PG8_SB
#undef PG8_STAGE
#undef PG8_LDA
#undef PG8_LDB
#undef PG8_MMA
#undef PG8_WAIT_V
#undef PG8_WAIT_L
#undef PG8_BAR
#undef PG8_SCHED
#undef PG8_APTR
#undef PG8_BPTR
}
}
using pg8::Unit;

struct EpiBf16Split {
    static constexpr bool PERM = true;
    u16* base[3]; int split_tiles; int ldc; float* lr; int lr_tile;
    int row_base = 0;
    DI void operator()(const f32x4 (&acc)[2][2][4][2], const Unit& u, int wr, int wc, int fr, int fq) const {
        const int row0 = row_base + u.pm * 256 + wr * 64 + fr;
        if (u.pn == lr_tile) {
            if (wc == 0) {
#pragma unroll
                for (int ai = 0; ai < 2; ++ai)
#pragma unroll
                    for (int m = 0; m < 4; ++m) { float* rp = lr + (size_t)(row0 + ai * 128 + m * 16) * 32 + 8 * fq;
                        *(f32x4*)(rp) = acc[ai][0][m][0]; *(f32x4*)(rp + 4) = acc[ai][0][m][1]; }
            }
            return;
        }
        const int t = u.pn / split_tiles; u16* b = t == 0 ? base[0] : (t == 1 ? base[1] : base[2]);
        const int col0 = (u.pn - t * split_tiles) * 256 + wc * 32 + 8 * fq;
#pragma unroll
        for (int ai = 0; ai < 2; ++ai)
#pragma unroll
            for (int m = 0; m < 4; ++m) { u16* rowp = b + (size_t)(row0 + ai * 128 + m * 16) * ldc + col0;
#pragma unroll
                for (int bj = 0; bj < 2; ++bj) { const f32x4 v0 = acc[ai][bj][m][0], v1 = acc[ai][bj][m][1];
                    u32x4 w; w.x = pk2(v0[0], v0[1]); w.y = pk2(v0[2], v0[3]); w.z = pk2(v1[0], v1[1]); w.w = pk2(v1[2], v1[3]);
                    *(u32x4*)(rowp + bj * 128) = w; } }
    }
};
struct EpiPair {
    static constexpr bool PERM = true;
    unsigned* GA;
    DI void operator()(const f32x4 (&acc)[2][2][4][2], const Unit& u, int wr, int wc, int fr, int fq) const {
        const int blk = u.pn >> 2, dir = (u.pn >> 1) & 1, half = u.pn & 1;
        const int row0 = u.pm * 256 + wr * 64 + fr;
        unsigned* ga = GA + (size_t)dir * M * LW + blk * 256 + half * 128 + wc * 32 + 8 * fq;
#pragma unroll
        for (int ai = 0; ai < 2; ++ai)
#pragma unroll
            for (int m = 0; m < 4; ++m) { unsigned* rp = ga + (size_t)(row0 + ai * 128 + m * 16) * LW;
#pragma unroll
                for (int n = 0; n < 2; ++n) { u32x4 w;
#pragma unroll
                    for (int j = 0; j < 4; ++j) w[j] = pk2(acc[ai][0][m][n][j], acc[ai][1][m][n][j]);
                    *(u32x4*)(rp + 4 * n) = w; } }
    }
};
DI void gate_au(unsigned w, float z, float ba, float bx, float c8, float& a, float& u) {
    const float r = sigmoid_f(lo_bf(w) + ba), ig = sigmoid_f(hi_bf(w) + bx);
    a = fexp(-c8 * r); u = __builtin_amdgcn_sqrtf(fmaxf(1.f - a * a, 0.f)) * ig * z;
}

DI void phase_prep(const Params& p, unsigned char* shm) {
    const int tid = threadIdx.x;
    float* scS = (float*)shm;
    float* red = scS + 5 * 1024;
    float* MOD = (float*)(p.ws + OFF_MOD);
    for (int i = tid; i < 5 * 1024; i += 512) { const int v = i >> 10, k = i & 1023; const float cv = v < 4 ? p.in[1][v * 1024 + k] : p.in[3][k]; scS[i] = silu_f(cv); }
    __syncthreads();
    for (int item = blockIdx.x; item < 192; item += gridDim.x) {
        const int layer = item / 96, n0 = (item % 96) * 32, col = tid & 31, kg = tid >> 5;
        float a0 = 0.f, a1 = 0.f, a2 = 0.f, a3 = 0.f, a4 = 0.f;
        const float* w = p.in[4] + (size_t)layer * 1024 * 3072 + n0 + col;
#pragma unroll 16
        for (int kk = 0; kk < 64; ++kk) { const int k = kg * 64 + kk; const float wv = w[(size_t)k * 3072];
            a0 += scS[k] * wv; a1 += scS[1024 + k] * wv; a2 += scS[2048 + k] * wv; a3 += scS[3072 + k] * wv; a4 += scS[4096 + k] * wv; }
        red[(kg * 5 + 0) * 32 + col] = a0; red[(kg * 5 + 1) * 32 + col] = a1; red[(kg * 5 + 2) * 32 + col] = a2; red[(kg * 5 + 3) * 32 + col] = a3; red[(kg * 5 + 4) * 32 + col] = a4;
        __syncthreads();
        if (tid < 160) { const int v = tid >> 5, c2 = tid & 31; float s = 0.f;
#pragma unroll
            for (int q = 0; q < 16; ++q) s += red[(q * 5 + v) * 32 + c2];
            MOD[(layer * 5 + v) * 3072 + n0 + c2] = s + p.in[5][layer * 3072 + n0 + c2]; }
        __syncthreads();
    }
}
DI void phase_transposes(const Params& p, unsigned char* shm, int wgi, int nwg) {
    const int tid = threadIdx.x;
    float* tile = (float*)shm;
    constexpr int T0 = 16 * 49, T1 = T0 + 256, T2 = T1 + 640, T3 = T2 + 320, T4 = T3 + 320;
    for (int tb = wgi; tb < T4; tb += 4 * nwg) {
        const float* src[4]; u16* dst[4]; int sld[4], dld[4], Nn[4], k0[4], n0[4]; bool valid[4];
#pragma unroll
        for (int u = 0; u < 4; ++u) {
            const int tl = tb + u * nwg; valid[u] = tl < T4; const int tc = valid[u] ? tl : 0; int kt, ntl;
            if (tc < T0) { kt = tc / 49; ntl = tc % 49; src[u] = p.in[8]; sld[u] = 3104; Nn[u] = 3104; dst[u] = (u16*)(p.ws + OFF_WT1); dld[u] = 1024; }
            else if (tc < T1) { const int t = tc - T0; kt = t / 16; ntl = t % 16; src[u] = p.in[14]; sld[u] = 1024; Nn[u] = 1024; dst[u] = (u16*)(p.ws + OFF_WT2); dld[u] = 1024; }
            else if (tc < T2) { const int t = tc - T1; kt = t / 40; ntl = t % 40; src[u] = p.in[15]; sld[u] = 2560; Nn[u] = 2560; dst[u] = (u16*)(p.ws + OFF_WT3); dld[u] = 1024; }
            else if (tc < T3) { const int t = tc - T2; kt = t / 16; ntl = t % 16; src[u] = p.in[28]; sld[u] = 1024; Nn[u] = 1024; dst[u] = (u16*)(p.ws + OFF_WT5); dld[u] = 1280; }
            else { const int t = tc - T3; const int j = t >> 3, tt = t & 7; kt = tt >> 1; ntl = tt & 1;
                const int gate = j / 10, rem = j % 10, blk = rem >> 1, half = rem & 1, dir = gate >> 1, isx = gate & 1;
                const float* gp = gate == 0 ? p.in[18] : (gate == 1 ? p.in[20] : (gate == 2 ? p.in[23] : p.in[25]));
                src[u] = gp + blk * 65536 + half * 128; sld[u] = 256; Nn[u] = 128;
                dst[u] = (u16*)(p.ws + OFF_WT4) + (size_t)((blk * 4 + dir * 2 + half) * 256 + isx * 128) * 256; dld[u] = 256; }
            k0[u] = kt * 64; n0[u] = ntl * 64;
        }
        float v[4][8];
#pragma unroll
        for (int u = 0; u < 4; ++u)
#pragma unroll
            for (int i = 0; i < 8; ++i) { const int e = tid + i * 512, kr = e >> 6, nc = e & 63;
                v[u][i] = (n0[u] + nc < Nn[u]) ? src[u][(size_t)(k0[u] + kr) * sld[u] + n0[u] + nc] : 0.f; }
        __syncthreads();
#pragma unroll
        for (int u = 0; u < 4; ++u)
#pragma unroll
            for (int i = 0; i < 8; ++i) { const int e = tid + i * 512, kr = e >> 6, nc = e & 63; tile[u * 4160 + kr * 65 + nc] = v[u][i]; }
        __syncthreads();
#pragma unroll
        for (int u = 0; u < 4; ++u) if (valid[u]) {
#pragma unroll
            for (int i = 0; i < 4; ++i) { const int pi = tid + i * 512, nr = pi >> 5, kc = (pi & 31) * 2;
                if (n0[u] + nr < Nn[u]) *(unsigned*)(dst[u] + (size_t)(n0[u] + nr) * dld[u] + k0[u] + kc) = pk2(tile[u * 4160 + kc * 65 + nr], tile[u * 4160 + (kc + 1) * 65 + nr]); } }
    }
}

DI const float* row_src(const Params& p, int row) { return row < MX ? p.in[0] + (size_t)row * D : p.in[2] + (size_t)(row - MX) * D; }
DI int row_perm(int row) { if (row >= MX) return row; const int b = row >> 13, t = row & 8191; return (b << 13) + (t & 63) * 128 + (t >> 6); }

DI void phase_h0(const Params& p, int wgi, int nwg) {
    const int wave = threadIdx.x >> 6, lane = threadIdx.x & 63;
    const float* MOD = (const float*)(p.ws + OFF_MOD);
    u16* H = (u16*)(p.ws + OFF_R0);
    for (int row = wgi * 16 + wave * 2; row < M; row += nwg * 16) {
        const int vec = row < MX ? row >> 13 : 4;
        const float* mod = MOD + (size_t)vec * 3072;
        f32x4 v[2][4]; float ss[2] = {0.f, 0.f};
#pragma unroll
        for (int r = 0; r < 2; ++r) { const float* src = row_src(p, row + r);
#pragma unroll
            for (int i = 0; i < 4; ++i) v[r][i] = ntload((const f32x4*)(src + i * 256 + lane * 4)); }
#pragma unroll
        for (int r = 0; r < 2; ++r) {
#pragma unroll
            for (int i = 0; i < 4; ++i) ss[r] += v[r][i][0] * v[r][i][0] + v[r][i][1] * v[r][i][1] + v[r][i][2] * v[r][i][2] + v[r][i][3] * v[r][i][3];
            ss[r] = rsqrtf(wave_sum(ss[r]) * (1.f / 1024.f) + 1e-6f); }
#pragma unroll
        for (int i = 0; i < 4; ++i) { const int c = i * 256 + lane * 4;
            const f32x4 g = *(const f32x4*)(p.in[6] + c), sh = *(const f32x4*)(mod + c), sc = *(const f32x4*)(mod + 1024 + c);
#pragma unroll
            for (int r = 0; r < 2; ++r) { float o[4];
#pragma unroll
                for (int j = 0; j < 4; ++j) o[j] = v[r][i][j] * ss[r] * g[j] * (1.f + sc[j]) + sh[j];
                u32x2 w; w.x = pk2(o[0], o[1]); w.y = pk2(o[2], o[3]); *(u32x2*)(H + (size_t)(row + r) * D + c) = w; } }
    }
}

DI void phase_gla_chunk(const Params& p, unsigned char* shm, float* outbuf) {
    const int tid = threadIdx.x, wave = tid >> 6, lane = tid & 63, l15 = lane & 15, lg4 = lane >> 4;
    float* lrS = (float*)shm;
    float* wgS = lrS + 64 * 32;
    float* bgS = wgS + 2 * 16 * 128;
    float* totS = bgS + 256;
    u16* qtS = (u16*)(totS + 512);
    u16* kbS = qtS + 64 * 136;
    u16* PS = kbS + 64 * 136;
    u16* vTS = PS + 64 * 72;
    u16* ktS = vTS + 256 * 72;
    const float* LR = (const float*)(p.ws + OFF_LR);
    const u16* QK = (const u16*)(p.ws + OFF_R1);
    const u16* V = (const u16*)(p.ws + OFF_R2);
    u16* QX = (u16*)(p.ws + OFF_R4);
    u16* KT = (u16*)outbuf;
    u16* VT = (u16*)(p.ws + OFF_VT);
    float* EL = (float*)(p.ws + OFF_EL);
    u16* OINTRA = (u16*)(p.ws + OFF_R0);
    int h_loaded = -1;
    for (int item = blockIdx.x; item < NCH * 4; item += gridDim.x) {
        const int cidx = item >> 2, h = item & 3, row0 = cidx * 64;
        u16 qraw[16], kraw[16], vraw[32]; float lrv[4];
        { const u16* qp = QK + (size_t)(row0 + (tid >> 7) * 16) * D + h * 128 + (tid & 127);
#pragma unroll
          for (int tt = 0; tt < 16; ++tt) { qraw[tt] = ntload(qp + (size_t)tt * D); kraw[tt] = ntload(qp + (size_t)tt * D + 512); }
          const u16* vp = V + (size_t)(row0 + (tid >> 8) * 32) * D + h * 256 + (tid & 255);
#pragma unroll
          for (int t2 = 0; t2 < 32; ++t2) vraw[t2] = ntload(vp + (size_t)t2 * D);
#pragma unroll
          for (int i = 0; i < 4; ++i) lrv[i] = ntload(LR + (size_t)row0 * 32 + tid + i * 512); }
        if (h != h_loaded) {
            float wv[8]; float bv = 0.f;
#pragma unroll
            for (int i = 0; i < 8; ++i) { const int e = tid + i * 512, d = e >> 11, r = (e >> 7) & 15, k = e & 127; wv[i] = (d ? p.in[11] : p.in[9])[r * 512 + h * 128 + k]; }
            if (tid < 256) { const int d = tid >> 7, k = tid & 127; bv = (d ? p.in[12] : p.in[10])[h * 128 + k]; }
#pragma unroll
            for (int i = 0; i < 8; ++i) wgS[tid + i * 512] = wv[i];
            if (tid < 256) bgS[tid] = bv;
            h_loaded = h;
        }
#pragma unroll
        for (int i = 0; i < 4; ++i) lrS[tid + i * 512] = lrv[i];
        {
            const int v = tid & 255, th = tid >> 8;
            unsigned pw[16];
#pragma unroll
            for (int t2 = 0; t2 < 16; ++t2) pw[t2] = (unsigned)vraw[2 * t2] | ((unsigned)vraw[2 * t2 + 1] << 16);
#pragma unroll
            for (int q = 0; q < 4; ++q) { const u32x4 w = {pw[4 * q], pw[4 * q + 1], pw[4 * q + 2], pw[4 * q + 3]};
                *(u32x4*)(vTS + v * 72 + th * 32 + q * 8) = w; }
        }
        __syncthreads();
        {
            u16* g = VT + (size_t)(cidx * 4 + h) * 16384;
#pragma unroll
            for (int j = 0; j < 4; ++j) { const int id = tid + j * 512; *(u32x4*)(g + id * 8) = *(const u32x4*)(vTS + (id >> 3) * 72 + (id & 7) * 8); }
        }
        f32x4 pacc[2] = {{0.f, 0.f, 0.f, 0.f}, {0.f, 0.f, 0.f, 0.f}};
#pragma unroll
        for (int dir = 0; dir < 2; ++dir) {
            const int k = tid & 127, tg = tid >> 7;
            float wreg[16];
#pragma unroll
            for (int r = 0; r < 16; ++r) wreg[r] = wgS[(dir * 16 + r) * 128 + k];
            const float bgv = bgS[dir * 128 + k];
            float lg[16];
#pragma unroll
            for (int tt = 0; tt < 16; ++tt) { const int t = tg * 16 + tt; float z = bgv;
#pragma unroll
                for (int r = 0; r < 16; ++r) z += lrS[t * 32 + dir * 16 + r] * wreg[r];
                lg[tt] = -(fmaxf(-z, 0.f) + flog(1.f + fexp(-fabsf(z)))) * (1.f / 16.f); }
            float run = 0.f;
            if (dir == 0) {
#pragma unroll
                for (int tt = 0; tt < 16; ++tt) { run += lg[tt]; lg[tt] = run; }
            } else {
#pragma unroll
                for (int tt = 15; tt >= 0; --tt) { run += lg[tt]; lg[tt] = run; }
            }
            totS[tg * 128 + k] = run;
            __syncthreads();
            float off = 0.f, total = 0.f;
#pragma unroll
            for (int g2 = 0; g2 < 4; ++g2) { const float tv = totS[g2 * 128 + k]; total += tv; if (dir == 0 ? (g2 < tg) : (g2 > tg)) off += tv; }
            unsigned kh[8];
            u16* qx = QX + (size_t)dir * M * 512;
#pragma unroll
            for (int t2 = 0; t2 < 8; ++t2) {
                float khv[2];
#pragma unroll
                for (int e = 0; e < 2; ++e) { const int tt = 2 * t2 + e, t = tg * 16 + tt;
                    const float cum = lg[tt] + off;
                    const float qv = bf2f(qraw[tt]) * 0.08838834764831845f;
                    const float kv = bf2f(kraw[tt]);
                    const u16 qt = f2bf(qv * fexp(cum));
                    qtS[t * 136 + k] = qt;
                    kbS[t * 136 + k] = f2bf(kv * fexp(-cum));
                    khv[e] = kv * fexp(total - cum); }
                kh[t2] = pk2(khv[0], khv[1]);
            }
            { const u32x4 w0 = {kh[0], kh[1], kh[2], kh[3]}, w1 = {kh[4], kh[5], kh[6], kh[7]};
              *(u32x4*)(ktS + k * 72 + tg * 16) = w0; *(u32x4*)(ktS + k * 72 + tg * 16 + 8) = w1; }
            if (tg == 0) EL[((size_t)dir * NCH + cidx) * 512 + h * 128 + k] = fexp(total);
            __syncthreads();
            {
#pragma unroll
                for (int j = 0; j < 2; ++j) { const int id = tid + j * 512;
                    { const int t_ = id >> 4, pc = id & 15, ks_ = pc >> 2, d_ = pc & 3;
                      const u32x2 lo = *(const u32x2*)(qtS + t_ * 136 + ks_ * 32 + 4 * d_), hi = *(const u32x2*)(qtS + t_ * 136 + ks_ * 32 + 16 + 4 * d_);
                      const u32x4 w = {lo.x, lo.y, hi.x, hi.y};
                      *(u32x4*)(qx + (size_t)(row0 + t_) * 512 + h * 128 + pc * 8) = w; }
                    *(u32x4*)(KT + (((size_t)dir * NCH + cidx) * 4 + h) * 8192 + id * 8) = *(const u32x4*)(ktS + (id >> 3) * 72 + (id & 7) * 8); }
            }
#pragma unroll
            for (int x = 0; x < 2; ++x) { const int id = wave * 2 + x, it = id >> 2, jt = id & 3;
                if (dir == 0 ? (jt <= it) : (jt >= it)) {
                    f32x4 a4 = {0.f, 0.f, 0.f, 0.f};
#pragma unroll
                    for (int ks = 0; ks < 4; ++ks) { const bf16x8 a = *(const bf16x8*)(qtS + (it * 16 + l15) * 136 + ks * 32 + lg4 * 8);
                        const bf16x8 b = *(const bf16x8*)(kbS + (jt * 16 + l15) * 136 + ks * 32 + lg4 * 8);
                        a4 = __builtin_amdgcn_mfma_f32_16x16x32_bf16(a, b, a4, 0, 0, 0); }
#pragma unroll
                    for (int r = 0; r < 4; ++r) { const int i = it * 16 + lg4 * 4 + r, j = jt * 16 + l15;
                        const bool keep = dir == 0 ? (j <= i) : (j >= i); pacc[x][r] += keep ? a4[r] : 0.f; }
                }
            }
            __syncthreads();
        }
#pragma unroll
        for (int x = 0; x < 2; ++x) { const int id = wave * 2 + x, it = id >> 2, jt = id & 3;
#pragma unroll
            for (int r = 0; r < 4; ++r) PS[(it * 16 + lg4 * 4 + r) * 72 + jt * 16 + l15] = f2bf(pacc[x][r]); }
        __syncthreads();
#pragma unroll
        for (int x = 0; x < 2; ++x) { const int vt = wave * 2 + x;
            const bf16x8 av0 = *(const bf16x8*)(vTS + (vt * 16 + l15) * 72 + lg4 * 8), av1 = *(const bf16x8*)(vTS + (vt * 16 + l15) * 72 + 32 + lg4 * 8);
#pragma unroll
            for (int it = 0; it < 4; ++it) {
                const bf16x8 b0 = *(const bf16x8*)(PS + (it * 16 + l15) * 72 + lg4 * 8), b1 = *(const bf16x8*)(PS + (it * 16 + l15) * 72 + 32 + lg4 * 8);
                f32x4 a4 = {0.f, 0.f, 0.f, 0.f};
                a4 = __builtin_amdgcn_mfma_f32_16x16x32_bf16(av0, b0, a4, 0, 0, 0);
                a4 = __builtin_amdgcn_mfma_f32_16x16x32_bf16(av1, b1, a4, 0, 0, 0);
                u32x2 w; w.x = pk2(a4[0], a4[1]); w.y = pk2(a4[2], a4[3]);
                *(u32x2*)(OINTRA + (size_t)(row0 + it * 16 + l15) * D + h * 256 + vt * 16 + lg4 * 4) = w; }
        }
        __syncthreads();
    }
}

template <int MODE> DI void phase_gla_seq(const Params& p, unsigned char* shm, const float* outbuf) {
    const int tid = threadIdx.x, wave = __builtin_amdgcn_readfirstlane(tid >> 6), lane = tid & 63, l15 = lane & 15, lg4 = lane >> 4;
    constexpr int QS_B = 64 * 288, KS_B = 128 * 144, VS_B = 32 * 144, BUF_B = QS_B + KS_B + VS_B + 512;
    constexpr int SF_OFF = 2 * BUF_B, SF_B = 8192;
    const u16* VT = (const u16*)(p.ws + OFF_VT);
    const float* ELb = (const float*)(p.ws + OFF_EL);
#define SEQ_BAR() do { __builtin_amdgcn_fence(__ATOMIC_RELEASE, "workgroup"); __builtin_amdgcn_s_barrier(); __builtin_amdgcn_fence(__ATOMIC_ACQUIRE, "workgroup"); } while (0)
    for (int item0 = blockIdx.x; item0 < 256; item0 += gridDim.x) {
        const int item = (((item0 & 7) * 4 + (item0 >> 6)) << 3) | ((item0 >> 3) & 7);
        const int vs = item & 7, dir = (item >> 3) & 1, h = (item >> 4) & 3, b = item >> 6;
        const unsigned char* QX = (const unsigned char*)((const u16*)(p.ws + OFF_R4) + (size_t)dir * M * 512 + h * 128);
        const unsigned char* KT = (const unsigned char*)((const u16*)outbuf + (size_t)dir * NCH * 4 * 8192 + (size_t)h * 8192);
        const unsigned char* VTb = (const unsigned char*)(VT + (size_t)h * 16384 + vs * 32 * 64);
        const unsigned char* EL = (const unsigned char*)(ELb + (size_t)dir * NCH * 512 + h * 128);
        u16* OI = (u16*)(p.ws + (dir ? OFF_R2 : OFF_R1));
#define SEQ_CIDX(s) ((s) < 4 ? 512 + 4 * b + (dir ? 3 - (s) : (s)) : 128 * b + (dir ? 127 - ((s) - 4) : ((s) - 4)))
        __syncthreads();
        *(u32x4*)(shm + SF_OFF + tid * 16) = (u32x4){0u, 0u, 0u, 0u};
        if (wave >= 4) {
            const int lt = tid - 256;
            unsigned soff[10], doff[10]; int kind[10];
#pragma unroll
            for (int i = 0; i < 10; ++i) { int id = lt + i * 256; if (id > 2335) id = 2335;
                if (id < 1024) { kind[i] = 0; soff[i] = (unsigned)((id >> 4) * 1024 + (id & 15) * 16); doff[i] = (unsigned)((id >> 4) * 288 + (id & 15) * 16); }
                else if (id < 2048) { const int j = id - 1024; kind[i] = 1; soff[i] = (unsigned)(j * 16); doff[i] = (unsigned)(QS_B + (j >> 3) * 144 + (j & 7) * 16); }
                else if (id < 2304) { const int j = id - 2048; kind[i] = 2; soff[i] = (unsigned)(j * 16); doff[i] = (unsigned)(QS_B + KS_B + (j >> 3) * 144 + (j & 7) * 16); }
                else { const int j = id - 2304; kind[i] = 3; soff[i] = (unsigned)(j * 16); doff[i] = (unsigned)(QS_B + KS_B + VS_B + j * 16); } }
            const bool last_valid = (lt + 9 * 256) < 2336;
            u32x4 ra[10], rb[10], rc[10], rd[10];
#define SEQ_LOAD(R, s) do { const int sl_ = (s) < 132 ? (s) : 131; const int ci = SEQ_CIDX(sl_); \
                const unsigned char* b0 = QX + (size_t)ci * 65536; const unsigned char* b1 = KT + (size_t)ci * 65536; \
                const unsigned char* b2 = VTb + (size_t)ci * 131072; const unsigned char* b3 = EL + (size_t)ci * 2048; \
                _Pragma("unroll") for (int i = 0; i < 10; ++i) { const unsigned char* bp = kind[i] == 0 ? b0 : (kind[i] == 1 ? b1 : (kind[i] == 2 ? b2 : b3)); \
                    if (i == 8) R[i] = ntload((const u32x4*)(bp + soff[i]));   \
                    else R[i] = *(const u32x4*)(bp + soff[i]); } } while (0)
#define SEQ_STORE(R, bi) do { unsigned char* bb = shm + (bi) * BUF_B; \
                _Pragma("unroll") for (int i = 0; i < 9; ++i) *(u32x4*)(bb + doff[i]) = R[i]; \
                *(u32x4*)(last_valid ? bb + doff[9] : shm + SF_OFF + 2 * SF_B + lt * 16) = R[9]; } while (0)
#define SEQ_STEP(R, s) do { if ((s) + 1 < 132) SEQ_STORE(R, ((s) + 1) & 1); SEQ_LOAD(R, (s) + 5); SEQ_BAR(); } while (0)
            SEQ_LOAD(ra, 0); SEQ_STORE(ra, 0);
            SEQ_LOAD(ra, 1); SEQ_LOAD(rb, 2); SEQ_LOAD(rc, 3); SEQ_LOAD(rd, 4);
            SEQ_BAR();
            for (int s = 0; s < 132; s += 4) { SEQ_STEP(ra, s); SEQ_STEP(rb, s + 1); SEQ_STEP(rc, s + 2); SEQ_STEP(rd, s + 3); }
#undef SEQ_LOAD
#undef SEQ_STORE
#undef SEQ_STEP
        } else if (wave < 2) {
            f32x4 S[8];
#pragma unroll
            for (int i = 0; i < 8; ++i) S[i] = (f32x4){0.f, 0.f, 0.f, 0.f};
            SEQ_BAR();
            for (int s = 0; s < 132; ++s) {
                const unsigned char* bb = shm + (s & 1) * BUF_B;
                bf16x8 ka[8][2], vb[2]; f32x4 el[8];
#pragma unroll
                for (int ts = 0; ts < 2; ++ts) { vb[ts] = *(const bf16x8*)(bb + QS_B + KS_B + (wave * 16 + l15) * 144 + ts * 64 + lg4 * 16);
#pragma unroll
                    for (int kt = 0; kt < 8; ++kt) ka[kt][ts] = *(const bf16x8*)(bb + QS_B + (kt * 16 + l15) * 144 + ts * 64 + lg4 * 16); }
#pragma unroll
                for (int kt = 0; kt < 8; ++kt) el[kt] = *(const f32x4*)(bb + QS_B + KS_B + VS_B + (kt * 16 + lg4 * 4) * 4);
#pragma unroll
                for (int kt = 0; kt < 8; ++kt) S[kt] = S[kt] * el[kt];
#pragma unroll
                for (int ts = 0; ts < 2; ++ts)
#pragma unroll
                    for (int kt = 0; kt < 8; ++kt) S[kt] = __builtin_amdgcn_mfma_f32_16x16x32_bf16(ka[kt][ts], vb[ts], S[kt], 0, 0, 0);
                unsigned char* sfp = shm + SF_OFF + ((s + 1) & 1) * SF_B + wave * 4096 + lane * 16;
#pragma unroll
                for (int ks = 0; ks < 4; ++ks) { u32x4 w; w.x = pk2(S[2 * ks][0], S[2 * ks][1]); w.y = pk2(S[2 * ks][2], S[2 * ks][3]);
                    w.z = pk2(S[2 * ks + 1][0], S[2 * ks + 1][1]); w.w = pk2(S[2 * ks + 1][2], S[2 * ks + 1][3]); *(u32x4*)(sfp + ks * 1024) = w; }
                SEQ_BAR();
            }
        } else {
            const int w2 = wave - 2;
            SEQ_BAR();
            for (int s = 0; s < 132; ++s) {
                const unsigned char* bb = shm + (s & 1) * BUF_B;
                const int cidx = SEQ_CIDX(s);
                const unsigned char* sfp = shm + SF_OFF + (s & 1) * SF_B + w2 * 4096 + lane * 16;
                bf16x8 sf[4]; u32x4 qf[4][4];
#pragma unroll
                for (int ks = 0; ks < 4; ++ks) sf[ks] = *(const bf16x8*)(sfp + ks * 1024);
#pragma unroll
                for (int tt = 0; tt < 4; ++tt)
#pragma unroll
                    for (int ks = 0; ks < 4; ++ks) qf[tt][ks] = *(const u32x4*)(bb + (tt * 16 + l15) * 288 + ks * 64 + lg4 * 16);
                f32x4 a4[4];
#pragma unroll
                for (int tt = 0; tt < 4; ++tt) a4[tt] = (f32x4){0.f, 0.f, 0.f, 0.f};
#pragma unroll
                for (int ks = 0; ks < 4; ++ks)
#pragma unroll
                    for (int tt = 0; tt < 4; ++tt) a4[tt] = __builtin_amdgcn_mfma_f32_16x16x32_bf16(sf[ks], __builtin_bit_cast(bf16x8, qf[tt][ks]), a4[tt], 0, 0, 0);
#pragma unroll
                for (int tt = 0; tt < 4; ++tt) { u32x2 w; w.x = pk2(a4[tt][0], a4[tt][1]); w.y = pk2(a4[tt][2], a4[tt][3]);
                    *(u32x2*)(OI + (size_t)(cidx * 64 + tt * 16 + l15) * D + h * 256 + vs * 32 + w2 * 16 + lg4 * 4) = w; }
                SEQ_BAR();
            }
        }
#undef SEQ_CIDX
    }
#undef SEQ_BAR
}

DI void phase_gla_combine(const Params& p, int row_lo, int row_hi, int wgi, int nwg) {
    const int wave = threadIdx.x >> 6, lane = threadIdx.x & 63;
    const u16* O0 = (const u16*)(p.ws + OFF_R0); const u16* O1 = (const u16*)(p.ws + OFF_R1); const u16* O2 = (const u16*)(p.ws + OFF_R2);
    const u16* G = (const u16*)(p.ws + OFF_R3); u16* A2 = (u16*)(p.ws + OFF_R4);
    const int vc = (lane & 31) * 8;
    const f32x4 gn0 = *(const f32x4*)(p.in[13] + vc), gn1 = *(const f32x4*)(p.in[13] + vc + 4);
    const float gn[8] = {gn0[0], gn0[1], gn0[2], gn0[3], gn1[0], gn1[1], gn1[2], gn1[3]};
    for (int row = row_lo + wgi * 16 + wave * 2; row < row_hi; row += nwg * 16) {
        u32x4 a[2][2], b[2][2], c[2][2], g[2][2];
#pragma unroll
        for (int r = 0; r < 2; ++r)
#pragma unroll
            for (int q = 0; q < 2; ++q) { const size_t o = (size_t)(row + r) * D + q * 512 + lane * 8;
                a[r][q] = ntload((const u32x4*)(O0 + o)); b[r][q] = ntload((const u32x4*)(O1 + o)); c[r][q] = ntload((const u32x4*)(O2 + o)); g[r][q] = ntload((const u32x4*)(G + o)); }
#pragma unroll
        for (int r = 0; r < 2; ++r)
#pragma unroll
            for (int q = 0; q < 2; ++q) {
                float v[8]; float ss = 0.f;
#pragma unroll
                for (int j = 0; j < 4; ++j) { v[2 * j] = lo_bf(a[r][q][j]) + lo_bf(b[r][q][j]) + lo_bf(c[r][q][j]); v[2 * j + 1] = hi_bf(a[r][q][j]) + hi_bf(b[r][q][j]) + hi_bf(c[r][q][j]); }
#pragma unroll
                for (int j = 0; j < 8; ++j) ss += v[j] * v[j];
                ss += __shfl_xor(ss, 1); ss += __shfl_xor(ss, 2); ss += __shfl_xor(ss, 4); ss += __shfl_xor(ss, 8); ss += __shfl_xor(ss, 16);
                const float rstd = rsqrtf(ss * (1.f / 256.f) + 1e-6f);
                u32x4 w;
#pragma unroll
                for (int j = 0; j < 4; ++j) { const float g0 = lo_bf(g[r][q][j]), g1 = hi_bf(g[r][q][j]);
                    w[j] = pk2(v[2 * j] * rstd * gn[2 * j] * silu_f(g0), v[2 * j + 1] * rstd * gn[2 * j + 1] * silu_f(g1)); }
                *(u32x4*)(A2 + (size_t)(row + r) * D + q * 512 + lane * 8) = w;
            }
    }
}

DI void phase_h1(const Params& p, int row_lo, int row_hi, int wgi, int nwg) {
    const int wave = threadIdx.x >> 6, lane = threadIdx.x & 63;
    const float* MOD = (const float*)(p.ws + OFF_MOD);
    const u16* Y = (const u16*)(p.ws + OFF_Y);
    u16* H = (u16*)(p.ws + OFF_R0);
    for (int row = row_lo + wgi * 16 + wave * 2; row < row_hi; row += nwg * 16) {
        const int vec = row < MX ? row >> 13 : 4;
        const float* mod0 = MOD + (size_t)vec * 3072; const float* mod1 = MOD + (size_t)(5 + vec) * 3072;
        f32x4 v[2][4]; u32x2 yy[2][4];
#pragma unroll
        for (int r = 0; r < 2; ++r) { const float* src = row_src(p, row + r);
#pragma unroll
            for (int i = 0; i < 4; ++i) { const int c = i * 256 + lane * 4; v[r][i] = ntload((const f32x4*)(src + c)); yy[r][i] = ntload((const u32x2*)(Y + (size_t)(row + r) * D + c)); } }
        float rsy[2], rstd[2];
        f32x4 y[2][4];
#pragma unroll
        for (int r = 0; r < 2; ++r) { float ssy = 0.f;
#pragma unroll
            for (int i = 0; i < 4; ++i) { y[r][i] = (f32x4){lo_bf(yy[r][i].x), hi_bf(yy[r][i].x), lo_bf(yy[r][i].y), hi_bf(yy[r][i].y)};
                ssy += y[r][i][0] * y[r][i][0] + y[r][i][1] * y[r][i][1] + y[r][i][2] * y[r][i][2] + y[r][i][3] * y[r][i][3]; }
            rsy[r] = rsqrtf(wave_sum(ssy) * (1.f / 1024.f) + 1e-6f); }
        float ss[2] = {0.f, 0.f};
#pragma unroll
        for (int i = 0; i < 4; ++i) { const int c = i * 256 + lane * 4;
            const f32x4 np = *(const f32x4*)(p.in[7] + c), gt = *(const f32x4*)(mod0 + 2048 + c);
#pragma unroll
            for (int r = 0; r < 2; ++r)
#pragma unroll
                for (int j = 0; j < 4; ++j) { v[r][i][j] += gt[j] * (y[r][i][j] * rsy[r] * np[j]); ss[r] += v[r][i][j] * v[r][i][j]; } }
#pragma unroll
        for (int r = 0; r < 2; ++r) rstd[r] = rsqrtf(wave_sum(ss[r]) * (1.f / 1024.f) + 1e-6f);
#pragma unroll
        for (int i = 0; i < 4; ++i) { const int c = i * 256 + lane * 4;
            const f32x4 g = *(const f32x4*)(p.in[6] + 1024 + c), sh = *(const f32x4*)(mod1 + c), sc = *(const f32x4*)(mod1 + 1024 + c);
#pragma unroll
            for (int r = 0; r < 2; ++r) { float o[4];
#pragma unroll
                for (int j = 0; j < 4; ++j) o[j] = v[r][i][j] * rstd[r] * g[j] * (1.f + sc[j]) + sh[j];
                u32x2 w; w.x = pk2(o[0], o[1]); w.y = pk2(o[2], o[3]); *(u32x2*)(H + (size_t)row_perm(row + r) * D + c) = w; } }
    }
}

DI void phase_conv(const Params& p, float* outbuf) {
    const u16* Z = (const u16*)(p.ws + OFF_Z); u16* ZC = (u16*)outbuf;
    const float* cw = p.in[16]; const float* cb = p.in[17];
    const int total = (M / 8) * 160;
    for (int idx = blockIdx.x * 512 + threadIdx.x; idx < total; idx += gridDim.x * 512) {
        const int row0 = (idx / 160) * 8, ch = (idx % 160) * 8;
        const int pos0 = row0 < MX ? (row0 & 8191) : ((row0 - MX) & 255), len = row0 < MX ? 8192 : 256;
        u32x4 z[11];
#pragma unroll
        for (int i = 0; i < 11; ++i) { const int pp = pos0 + i - 2;
            z[i] = (pp >= 0 && pp < len) ? ntload((const u32x4*)(Z + (size_t)(row0 + i - 2) * LW + ch)) : (u32x4){0u, 0u, 0u, 0u}; }
        f32x4 w[4][2], bias[2];
#pragma unroll
        for (int j = 0; j < 4; ++j) { w[j][0] = *(const f32x4*)(cw + j * LW + ch); w[j][1] = *(const f32x4*)(cw + j * LW + ch + 4); }
        bias[0] = *(const f32x4*)(cb + ch); bias[1] = *(const f32x4*)(cb + ch + 4);
#pragma unroll
        for (int r = 0; r < 8; ++r) {
            f32x4 a0 = bias[0], a1 = bias[1];
#pragma unroll
            for (int j = 0; j < 4; ++j) { const u32x4 zz = z[r + j];
                a0[0] += w[j][0][0] * lo_bf(zz.x); a0[1] += w[j][0][1] * hi_bf(zz.x); a0[2] += w[j][0][2] * lo_bf(zz.y); a0[3] += w[j][0][3] * hi_bf(zz.y);
                a1[0] += w[j][1][0] * lo_bf(zz.z); a1[1] += w[j][1][1] * hi_bf(zz.z); a1[2] += w[j][1][2] * lo_bf(zz.w); a1[3] += w[j][1][3] * hi_bf(zz.w); }
            const u32x4 o = {pk2(a0[0], a0[1]), pk2(a0[2], a0[3]), pk2(a1[0], a1[1]), pk2(a1[2], a1[3])};
            *(u32x4*)(ZC + (size_t)(row0 + r) * LW + ch) = o;
        }
    }
}

DI void phase_lru_agg(const Params& p, const float* outbuf) {
    const unsigned* GAf = (const unsigned*)(p.ws + OFF_AU); const unsigned* GAb = GAf + (size_t)M * LW;
    const u16* ZC = (const u16*)outbuf;
    float* CA = (float*)(p.ws + OFF_CA); float* CU = (float*)(p.ws + OFF_CU);
    const int total = NCH * 320 * 2;
    for (int idx = blockIdx.x * 512 + threadIdx.x; idx < total; idx += gridDim.x * 512) {
        const int half = idx & 1, i2 = idx >> 1, c4 = i2 % 320, cidx = i2 / 320, ch = c4 * 4;
        const f32x4 baf = *(const f32x4*)(p.in[19] + ch), bxf = *(const f32x4*)(p.in[21] + ch), lf = *(const f32x4*)(p.in[22] + ch);
        const f32x4 bab = *(const f32x4*)(p.in[24] + ch), bxb = *(const f32x4*)(p.in[26] + ch), lb = *(const f32x4*)(p.in[27] + ch);
        f32x4 c8f, c8b;
#pragma unroll
        for (int j = 0; j < 4; ++j) { c8f[j] = 8.f * flog(1.f + fexp(-lf[j])); c8b[j] = 8.f * flog(1.f + fexp(-lb[j])); }
        const unsigned base = ((unsigned)cidx * 64u + half * 32u) * LW + ch;
        f32x4 Af = {1.f, 1.f, 1.f, 1.f}, Uf = {0.f, 0.f, 0.f, 0.f}, Pb = {1.f, 1.f, 1.f, 1.f}, Ub = {0.f, 0.f, 0.f, 0.f};
        u32x4 gfA[4], gbA[4], gfB[4], gbB[4]; u32x2 zcA[4], zcB[4];
#define AGG_LOAD(GF, GB, ZZ, tb) do { _Pragma("unroll") for (int q = 0; q < 4; ++q) { const unsigned o = base + (unsigned)((tb) * 4 + q) * LW; GF[q] = ntload((const u32x4*)(GAf + o)); GB[q] = ntload((const u32x4*)(GAb + o)); ZZ[q] = ntload((const u32x2*)(ZC + o)); } } while (0)
#define AGG_COMP(GF, GB, ZZ) do { _Pragma("unroll") for (int q = 0; q < 4; ++q) { \
                const float z[4] = {lo_bf(ZZ[q].x), hi_bf(ZZ[q].x), lo_bf(ZZ[q].y), hi_bf(ZZ[q].y)}; \
                _Pragma("unroll") for (int j = 0; j < 4; ++j) { float a, u; \
                    gate_au(GF[q][j], z[j], baf[j], bxf[j], c8f[j], a, u); Uf[j] = a * Uf[j] + u; Af[j] *= a; \
                    gate_au(GB[q][j], z[j], bab[j], bxb[j], c8b[j], a, u); Ub[j] += Pb[j] * u; Pb[j] *= a; } } } while (0)
        AGG_LOAD(gfA, gbA, zcA, 0);
        for (int tb = 0; tb < 8; tb += 2) {
            AGG_LOAD(gfB, gbB, zcB, tb + 1);
            AGG_COMP(gfA, gbA, zcA);
            if (tb + 2 < 8) AGG_LOAD(gfA, gbA, zcA, tb + 2);
            AGG_COMP(gfB, gbB, zcB);
        }
#undef AGG_LOAD
#undef AGG_COMP
        f32x4 Af1, Uf1, Pb1, Ub1;
#pragma unroll
        for (int j = 0; j < 4; ++j) { Af1[j] = __shfl_xor(Af[j], 1); Uf1[j] = __shfl_xor(Uf[j], 1); Pb1[j] = __shfl_xor(Pb[j], 1); Ub1[j] = __shfl_xor(Ub[j], 1); }
        if (half == 0) {
            f32x4 A, U, P, UB;
#pragma unroll
            for (int j = 0; j < 4; ++j) { A[j] = Af[j] * Af1[j]; U[j] = Af1[j] * Uf[j] + Uf1[j]; P[j] = Pb[j] * Pb1[j]; UB[j] = Ub[j] + Pb[j] * Ub1[j]; }
            const size_t o = (size_t)cidx * LW + ch;
            *(f32x4*)(CA + o) = A; *(f32x4*)(CU + o) = U; *(f32x4*)(CA + (size_t)NCH * LW + o) = P; *(f32x4*)(CU + (size_t)NCH * LW + o) = UB;
        }
    }
}
DI void phase_lru_carry(const Params& p) {
    const float* CA = (const float*)(p.ws + OFF_CA); const float* CU = (const float*)(p.ws + OFF_CU); float* HS = (float*)(p.ws + OFF_HS);
    for (int idx = blockIdx.x * 512 + threadIdx.x; idx < 4 * 2 * LW; idx += gridDim.x * 512) {
        const int ch = idx % LW, dir = (idx / LW) & 1, b = idx / (2 * LW);
        float h = 0.f;
        for (int s0 = 0; s0 < 132; s0 += 12) {
            size_t o[12]; float a[12], u[12];
#pragma unroll
            for (int q = 0; q < 12; ++q) { const int s = s0 + q; const int cidx = s < 4 ? 512 + 4 * b + (dir ? 3 - s : s) : 128 * b + (dir ? 127 - (s - 4) : (s - 4));
                o[q] = ((size_t)dir * NCH + cidx) * LW + ch; a[q] = CA[o[q]]; u[q] = CU[o[q]]; }
#pragma unroll
            for (int q = 0; q < 12; ++q) { HS[o[q]] = h; h = a[q] * h + u[q]; }
        }
    }
}
DI void phase_lru_apply(const Params& p, unsigned char* shm, float* outbuf) {
    const int tid = threadIdx.x;
    float* hf = (float*)shm;
    const unsigned* GAf = (const unsigned*)(p.ws + OFF_AU); const unsigned* GAb = GAf + (size_t)M * LW;
    const float* HS = (const float*)(p.ws + OFF_HS);
    const u16* G2 = (const u16*)(p.ws + OFF_G2); u16* ZA = (u16*)outbuf;
    for (int wi = blockIdx.x; wi < 1280; wi += gridDim.x) {
        const int item = wi * 2 + (tid >> 8), cidx = item / 5, ch = (item % 5) * 256 + (tid & 255);
        const unsigned base = (unsigned)cidx * 64u * LW + ch;
        const float baf = p.in[19][ch], bxf = p.in[21][ch], c8f = 8.f * flog(1.f + fexp(-p.in[22][ch]));
        const float bab = p.in[24][ch], bxb = p.in[26][ch], c8b = 8.f * flog(1.f + fexp(-p.in[27][ch]));
        float h = HS[(size_t)cidx * LW + ch];
        const float hb0 = HS[((size_t)NCH + cidx) * LW + ch];
        for (int tb = 0; tb < 2; ++tb) {
            unsigned w[32]; u16 z[32];
#pragma unroll
            for (int q = 0; q < 32; ++q) { const unsigned o = base + (unsigned)(tb * 32 + q) * LW; w[q] = ntload(GAf + o); z[q] = ZA[o]; }
#pragma unroll
            for (int q = 0; q < 32; ++q) { float a, u; gate_au(w[q], bf2f(z[q]), baf, bxf, c8f, a, u); h = a * h + u; hf[(tb * 32 + q) * 512 + tid] = h; }
        }
        h = hb0;
        for (int tb = 3; tb >= 0; --tb) {
            unsigned w[16]; u16 z[16], g[16];
#pragma unroll
            for (int q = 0; q < 16; ++q) { const unsigned o = base + (unsigned)(tb * 16 + q) * LW; w[q] = ntload(GAb + o); z[q] = ntload(ZA + o); g[q] = ntload(G2 + o); }
#pragma unroll
            for (int q = 15; q >= 0; --q) { float a, u; gate_au(w[q], bf2f(z[q]), bab, bxb, c8b, a, u); h = a * h + u;
                const float tot = hf[(tb * 16 + q) * 512 + tid] + h;
                ZA[base + (unsigned)(tb * 16 + q) * LW] = f2bf(tot * silu_f(bf2f(g[q]))); }
        }
    }
}

DI void phase_final(const Params& p) {
    const int wave = threadIdx.x >> 6, lane = threadIdx.x & 63;
    const float* MOD = (const float*)(p.ws + OFF_MOD);
    const u16* Y = (const u16*)(p.ws + OFF_Y); const u16* Y2 = (const u16*)(p.ws + OFF_Y2);
    for (int row = blockIdx.x * 16 + wave * 2; row < MX; row += gridDim.x * 16) {
        const int vec = row >> 13;
        const float* gt0 = MOD + (size_t)vec * 3072 + 2048; const float* gt1 = MOD + (size_t)(5 + vec) * 3072 + 2048;
        f32x4 v[2][4]; u32x2 yy[2][4], zz[2][4];
#pragma unroll
        for (int r = 0; r < 2; ++r) { const float* src = p.in[0] + (size_t)(row + r) * D; const size_t prow = (size_t)row_perm(row + r);
#pragma unroll
            for (int i = 0; i < 4; ++i) { const int c = i * 256 + lane * 4; v[r][i] = ntload((const f32x4*)(src + c));
                yy[r][i] = ntload((const u32x2*)(Y + (size_t)(row + r) * D + c)); zz[r][i] = ntload((const u32x2*)(Y2 + prow * D + c)); } }
        f32x4 y[2][4], y2[2][4]; float rsy[2], rs2[2];
#pragma unroll
        for (int r = 0; r < 2; ++r) { float ssy = 0.f, ss2 = 0.f;
#pragma unroll
            for (int i = 0; i < 4; ++i) { y[r][i] = (f32x4){lo_bf(yy[r][i].x), hi_bf(yy[r][i].x), lo_bf(yy[r][i].y), hi_bf(yy[r][i].y)};
                y2[r][i] = (f32x4){lo_bf(zz[r][i].x), hi_bf(zz[r][i].x), lo_bf(zz[r][i].y), hi_bf(zz[r][i].y)};
#pragma unroll
                for (int j = 0; j < 4; ++j) { ssy += y[r][i][j] * y[r][i][j]; ss2 += y2[r][i][j] * y2[r][i][j]; } }
            rsy[r] = rsqrtf(wave_sum(ssy) * (1.f / 1024.f) + 1e-6f); rs2[r] = rsqrtf(wave_sum(ss2) * (1.f / 1024.f) + 1e-6f); }
#pragma unroll
        for (int i = 0; i < 4; ++i) { const int c = i * 256 + lane * 4;
            const f32x4 np0 = *(const f32x4*)(p.in[7] + c), np1 = *(const f32x4*)(p.in[7] + 1024 + c), g0 = *(const f32x4*)(gt0 + c), g1 = *(const f32x4*)(gt1 + c);
#pragma unroll
            for (int r = 0; r < 2; ++r) { f32x4 o;
#pragma unroll
                for (int j = 0; j < 4; ++j) { const float x1 = v[r][i][j] + g0[j] * (y[r][i][j] * rsy[r] * np0[j]); o[j] = x1 + g1[j] * (y2[r][i][j] * rs2[r] * np1[j]); }
                ntstore(o, (f32x4*)(p.out + (size_t)(row + r) * D + c)); } }
    }
}


#define XB_TMO      128
#define XB_XCNT(j)  (256  + 64 * (j))
#define XB_XSUB(j)  (1280 + 64 * (j))
#define XB_XGEN(j)  (2304 + 64 * (j))
#define XB_TOP      3328
#define XB_TOPGEN   3392
#define XCD_BAR_WORDS 3456
#define XB_SPIN_CAP (1u << 18)
DI unsigned xb_ld(unsigned* p)              { return __hip_atomic_load(p, __ATOMIC_RELAXED, __HIP_MEMORY_SCOPE_AGENT); }
DI unsigned xb_add(unsigned* p, unsigned v) { return __hip_atomic_fetch_add(p, v, __ATOMIC_RELAXED, __HIP_MEMORY_SCOPE_AGENT); }
DI unsigned xb_xcc_id() { return (unsigned)__builtin_amdgcn_s_getreg((3 << 11) | 20) & 0xFu; }
#define XB_SPIN(cond, bar) do { unsigned _sp = 0; while (cond) { __builtin_amdgcn_s_sleep(1); \
    if ((++_sp & 255u) == 0u) { if (xb_ld(&(bar)[XB_TMO])) break; if (_sp > XB_SPIN_CAP) { atomicAdd(&(bar)[XB_TMO], 1u); break; } } } } while (0)
struct XcdBarrier { unsigned* bar; unsigned x; volatile LAS unsigned* st; };
DI XcdBarrier xcd_barrier_post(unsigned* bar, volatile LAS unsigned* st) {
    XcdBarrier b; b.bar = bar; b.x = xb_xcc_id(); b.st = st;
    if (threadIdx.x == 0) (void)xb_add(&bar[XB_XCNT(b.x)], 1u);
    return b;
}
DI void xcd_barrier_complete(unsigned* bar, unsigned x, unsigned& nloc, unsigned& nx) {
    const unsigned G = gridDim.x * gridDim.y * gridDim.z;
    unsigned sum, cnt, mine, sp = 0u;
    for (;;) {
        sum = 0u; cnt = 0u; mine = 0u;
#pragma unroll
        for (unsigned j = 0; j < 16; ++j) { const unsigned c = xb_ld(&bar[XB_XCNT(j)]); sum += c; cnt += (c > 0u) ? 1u : 0u; mine = (j == x) ? c : mine; }
        if (sum == G) break;
        __builtin_amdgcn_s_sleep(1);
        if ((++sp & 255u) == 0u) { if (xb_ld(&bar[XB_TMO])) break; if (sp > XB_SPIN_CAP) { atomicAdd(&bar[XB_TMO], 1u); break; } }
    }
    nloc = mine > 0u ? mine : 1u; nx = cnt > 0u ? cnt : 1u;
}
DI void xcd_barrier(const XcdBarrier& b) {
    asm volatile("s_waitcnt vmcnt(0)" ::: "memory");
    __syncthreads();
    if (threadIdx.x == 0) {
        unsigned* bar = b.bar;
        __builtin_amdgcn_s_waitcnt(0);
        unsigned nloc = b.st[0], nx = b.st[1];
        if (nloc == 0u) { xcd_barrier_complete(bar, b.x, nloc, nx); b.st[0] = nloc; b.st[1] = nx; }
        const unsigned old = xb_add(&bar[XB_XSUB(b.x)], 1u);
        const unsigned gen = old / nloc;
        if (old + 1u == (gen + 1u) * nloc) {
            __builtin_amdgcn_fence(__ATOMIC_RELEASE, "agent");
            asm volatile("s_waitcnt vmcnt(0)" ::: "memory");
            const unsigned og = xb_add(&bar[XB_TOP], 1u);
            const unsigned tg = og / nx;
            if (og + 1u == (tg + 1u) * nx) xb_add(&bar[XB_TOPGEN], 1u);
            else XB_SPIN(xb_ld(&bar[XB_TOPGEN]) == tg, bar);
            __builtin_amdgcn_fence(__ATOMIC_ACQUIRE, "agent");
            xb_add(&bar[XB_XGEN(b.x)], 1u);
            asm volatile("s_waitcnt vmcnt(0)" ::: "memory");
        } else {
            XB_SPIN(xb_ld(&bar[XB_XGEN(b.x)]) == gen, bar);
            __builtin_amdgcn_fence(__ATOMIC_ACQUIRE, "agent");
            asm volatile("s_waitcnt vmcnt(0)" ::: "memory");
        }
    }
    __syncthreads();
}

constexpr int NPHASE = 18;
__global__ void __launch_bounds__(512, 2) fwd_megakernel(Params p, int ph0, int ph1) {
    extern __shared__ __attribute__((aligned(16))) unsigned char shm[];
    __shared__ __attribute__((aligned(16))) unsigned xb_words[4];
    LAS unsigned char* lds = (LAS unsigned char*)shm;
    cg::grid_group grid = cg::this_grid();
    XcdBarrier xb; xb.bar = (unsigned*)(p.ws + OFF_BAR); xb.x = 0; xb.st = (volatile LAS unsigned*)xb_words;
    if (ph1 - ph0 > 1) { if (threadIdx.x < 4) xb_words[threadIdx.x] = 0u; __syncthreads(); xb = xcd_barrier_post((unsigned*)(p.ws + OFF_BAR), (volatile LAS unsigned*)xb_words); }
    pg8::StaticOrder S;
#define PHASE(k) if (((PH_MASK >> (k)) & 1) && ph0 <= (k) && (k) < ph1)
#define SYNC(k) if (ph0 <= (k) && (k) + 1 < ph1) { if (ph1 > NPHASE) grid.sync(); else xcd_barrier(xb); }
    PHASE(0) { phase_prep(p, shm); } SYNC(0);
    PHASE(1) {
        if (blockIdx.x < 64 && gridDim.x > 64) phase_transposes(p, shm, blockIdx.x, 64);
        else if (gridDim.x > 64) phase_h0(p, blockIdx.x - 64, gridDim.x - 64);
        else { phase_transposes(p, shm, blockIdx.x, gridDim.x); phase_h0(p, blockIdx.x, gridDim.x); }
    } SYNC(1);
    PHASE(2) {
        pg8::Gemm g = {(const u16*)(p.ws + OFF_R0), (const u16*)(p.ws + OFF_WT1), M, 3328, 1024, 1024, 1024, 0, 0};
        EpiBf16Split E; E.base[0] = (u16*)(p.ws + OFF_R1); E.base[1] = (u16*)(p.ws + OFF_R2); E.base[2] = (u16*)(p.ws + OFF_R3); E.split_tiles = 4; E.ldc = 1024; E.lr = (float*)(p.ws + OFF_LR); E.lr_tile = 12;
        S.init(g.M, g.N, gridDim.x, blockIdx.x); pg8::gemm_phase(lds, g, S, E);
    } SYNC(2);
    PHASE(3) { phase_gla_chunk(p, shm, p.out); } SYNC(3);
    PHASE(4) { phase_gla_seq<0>(p, shm, p.out); } SYNC(4);
    PHASE(5) { phase_gla_combine(p, MX, M, blockIdx.x, gridDim.x); } SYNC(5);
    PHASE(6) {
        if (blockIdx.x < 16) {
            pg8::Gemm g = {(const u16*)(p.ws + OFF_R4) + (size_t)MX * 1024, (const u16*)(p.ws + OFF_WT2), MC, 1024, 1024, 1024, 1024, 0, 0};
            EpiBf16Split E; E.base[0] = E.base[1] = E.base[2] = (u16*)(p.ws + OFF_Y); E.split_tiles = 64; E.ldc = 1024; E.lr = nullptr; E.lr_tile = -1; E.row_base = MX;
            S.init(g.M, g.N, 16, blockIdx.x); pg8::gemm_phase(lds, g, S, E);
        } else phase_gla_combine(p, 0, MX, blockIdx.x - 16, gridDim.x - 16);
    } SYNC(6);
    PHASE(7) {
        pg8::Gemm g = {(const u16*)(p.ws + OFF_R4), (const u16*)(p.ws + OFF_WT2), MX, 1024, 1024, 1024, 1024, 0, 0};
        EpiBf16Split E; E.base[0] = E.base[1] = E.base[2] = (u16*)(p.ws + OFF_Y); E.split_tiles = 64; E.ldc = 1024; E.lr = nullptr; E.lr_tile = -1;
        S.init(g.M, g.N, gridDim.x, blockIdx.x); pg8::gemm_phase(lds, g, S, E);
    } SYNC(7);
    PHASE(8) { phase_h1(p, MX, M, blockIdx.x, gridDim.x); } SYNC(8);
    PHASE(9) {
        if (blockIdx.x < 40) {
            pg8::Gemm g = {(const u16*)(p.ws + OFF_R0) + (size_t)MX * 1024, (const u16*)(p.ws + OFF_WT3), MC, 2560, 1024, 1024, 1024, 0, 0};
            EpiBf16Split E; E.base[0] = (u16*)(p.ws + OFF_Z); E.base[1] = E.base[2] = (u16*)(p.ws + OFF_G2); E.split_tiles = 5; E.ldc = 1280; E.lr = nullptr; E.lr_tile = -1; E.row_base = MX;
            S.init(g.M, g.N, 40, blockIdx.x); pg8::gemm_phase(lds, g, S, E);
        } else phase_h1(p, 0, MX, blockIdx.x - 40, gridDim.x - 40);
    } SYNC(9);
    PHASE(10) {
        pg8::Gemm g = {(const u16*)(p.ws + OFF_R0), (const u16*)(p.ws + OFF_WT3), MX, 2560, 1024, 1024, 1024, 0, 0};
        EpiBf16Split E; E.base[0] = (u16*)(p.ws + OFF_Z); E.base[1] = E.base[2] = (u16*)(p.ws + OFF_G2); E.split_tiles = 5; E.ldc = 1280; E.lr = nullptr; E.lr_tile = -1;
        S.init(g.M, g.N, gridDim.x, blockIdx.x); pg8::gemm_phase(lds, g, S, E);
    } SYNC(10);
    PHASE(11) { phase_conv(p, p.out); } SYNC(11);
    PHASE(12) {
        pg8::Gemm g = {(const u16*)p.out, (const u16*)(p.ws + OFF_WT4), M, 5120, 256, 1280, 256, 2, 512};
        EpiPair E; E.GA = (unsigned*)(p.ws + OFF_AU);
        S.init(g.M, g.N, gridDim.x, blockIdx.x); pg8::gemm_phase(lds, g, S, E);
    } SYNC(12);
    PHASE(13) { phase_lru_agg(p, p.out); } SYNC(13);
    PHASE(14) { phase_lru_carry(p); } SYNC(14);
    PHASE(15) { phase_lru_apply(p, shm, p.out); } SYNC(15);
    PHASE(16) {
        pg8::Gemm g = {(const u16*)p.out, (const u16*)(p.ws + OFF_WT5), MX, 1024, 1280, 1280, 1280, 0, 0};
        EpiBf16Split E; E.base[0] = E.base[1] = E.base[2] = (u16*)(p.ws + OFF_Y2); E.split_tiles = 64; E.ldc = 1024; E.lr = nullptr; E.lr_tile = -1;
        S.init(g.M, g.N, gridDim.x, blockIdx.x); pg8::gemm_phase(lds, g, S, E);
    } SYNC(16);
    PHASE(17) { phase_final(p); }
#undef PHASE
#undef SYNC
}

extern "C" void kernel_launch(void* const* d_in, const int* in_sizes, int n_in, void* d_out, int out_size, void* d_ws, size_t ws_size, hipStream_t stream) {
    constexpr size_t kDynLds = 131072;
    static int grid_blocks = 0;
    if (!grid_blocks) {
        hipFuncSetAttribute((const void*)fwd_megakernel, hipFuncAttributeMaxDynamicSharedMemorySize, (int)kDynLds);
        int dev = 0, cus = 0, per_cu = 0;
        hipGetDevice(&dev);
        hipDeviceGetAttribute(&cus, hipDeviceAttributeMultiprocessorCount, dev);
        hipOccupancyMaxActiveBlocksPerMultiprocessor(&per_cu, fwd_megakernel, 512, kDynLds);
        if (per_cu < 1) per_cu = 1;
        grid_blocks = cus * 1;
    }
    Params p{};
    for (int i = 0; i < 29; ++i) p.in[i] = (const float*)d_in[i];
    p.out = (float*)d_out; p.ws = (unsigned char*)d_ws;
#if MULTI_LAUNCH
    for (int k = 0; k < NPHASE; ++k) for (int rep = 0; rep <= ((REP_MASK >> k) & 1); ++rep) fwd_megakernel<<<dim3(grid_blocks), dim3(512), kDynLds, stream>>>(p, k, k + 1);
#else
    int ph0 = 0, ph1 = NPHASE;
    (void)hipMemsetAsync((unsigned char*)d_ws + OFF_BAR, 0, XCD_BAR_WORDS * sizeof(unsigned), stream);
    void* args[] = {&p, &ph0, &ph1};
    hipError_t e = hipLaunchCooperativeKernel((void*)fwd_megakernel, dim3(grid_blocks), dim3(512), args, kDynLds, stream);
    if (e != hipSuccess) fprintf(stderr, "cooperative launch failed: %s (grid %d)\n", hipGetErrorString(e), grid_blocks);
#endif
}
```

```cpp
#include <hip/hip_runtime.h>
#include <hip/hip_cooperative_groups.h>
#include <cstdio>
namespace cg = cooperative_groups;

#ifndef PH_MASK
#define PH_MASK 0xFFFFFF
#endif
#ifndef REP_MASK
#define REP_MASK 0
#endif
#ifndef EXTRA
#define EXTRA 0
#endif
#ifndef MULTI_LAUNCH
#define MULTI_LAUNCH 0
#endif

typedef unsigned short u16;
typedef short bf16x8 __attribute__((ext_vector_type(8)));
typedef float f32x4 __attribute__((ext_vector_type(4)));
typedef float f32x2 __attribute__((ext_vector_type(2)));
typedef unsigned u32x4 __attribute__((ext_vector_type(4)));
typedef unsigned u32x2 __attribute__((ext_vector_type(2)));
typedef __bf16 bfv2 __attribute__((ext_vector_type(2)));
#define LAS __attribute__((address_space(3)))
#define DI __device__ __forceinline__

constexpr int D = 1024, MX = 32768, MC = 1024, M = MX + MC;
constexpr int NCH = M / 64;
constexpr int LW = 1280;
constexpr size_t MiB = 1024 * 1024;
constexpr size_t OFF_Y = 0;
constexpr size_t OFF_R0 = 66 * MiB;
constexpr size_t OFF_R1 = 132 * MiB;
constexpr size_t OFF_R2 = 198 * MiB;
constexpr size_t OFF_R3 = 264 * MiB;
constexpr size_t OFF_R4 = 330 * MiB;
constexpr size_t OFF_VT = 396 * MiB;
constexpr size_t OFF_WT1 = 462 * MiB;
constexpr size_t OFF_WT2 = OFF_WT1 + 7 * MiB;
constexpr size_t OFF_LR = OFF_WT2 + 2 * MiB;
constexpr size_t OFF_EL = OFF_LR + 5 * MiB;
constexpr size_t OFF_MOD = 479 * MiB;
constexpr size_t OFF_WT3 = OFF_MOD + 1 * MiB;
constexpr size_t OFF_WT4 = OFF_WT3 + 5 * MiB;
constexpr size_t OFF_WT5 = OFF_WT4 + 3 * MiB;
constexpr size_t OFF_CA = OFF_WT5 + 3 * MiB;
constexpr size_t OFF_CU = OFF_CA + 6 * MiB;
constexpr size_t OFF_HS = OFF_CU + 6 * MiB;
constexpr size_t OFF_BAR = OFF_HS + 6 * MiB;
constexpr size_t OFF_AU = 66 * MiB;
constexpr size_t OFF_Z = 132 * MiB;
constexpr size_t OFF_G2 = 396 * MiB;
constexpr size_t OFF_Y2 = 66 * MiB;

struct Params {
    const float* in[29];
    float* out;
    unsigned char* ws;
};

template <class T> DI T ntload(const T* p) { return __builtin_nontemporal_load(p); }
template <class T> DI void ntstore(T v, T* p) { __builtin_nontemporal_store(v, p); }
DI float bf2f(u16 b) { return __uint_as_float(((unsigned)b) << 16); }
DI unsigned pk2(float lo, float hi) { f32x2 v = {lo, hi}; bfv2 b = __builtin_convertvector(v, bfv2); return __builtin_bit_cast(unsigned, b); }
DI u16 f2bf(float f) { return (u16)(pk2(f, 0.f) & 0xffffu); }
DI float lo_bf(unsigned w) { return __uint_as_float(w << 16); }
DI float hi_bf(unsigned w) { return __uint_as_float(w & 0xffff0000u); }
DI float wave_sum(float v) {
#pragma unroll
    for (int o = 32; o; o >>= 1) v += __shfl_xor(v, o);
    return v;
}
DI float fexp(float x) { return __builtin_amdgcn_exp2f(x * 1.4426950408889634f); }
DI float flog(float x) { return __builtin_amdgcn_logf(x) * 0.6931471805599453f; }
DI float sigmoid_f(float x) { return __builtin_amdgcn_rcpf(1.f + fexp(-x)); }
DI float silu_f(float x) { return x * sigmoid_f(x); }

namespace pg8 {
constexpr int BM = 256, BK = 64, HALF = 128, HTB = HALF * BK * 2, STAGE_BYTES = 8 * HTB, NXCD = 8, WGM = 8;
DI int lds_byte(int r, int c) { const int st = (r >> 4) * 2 + (c >> 5), rr = r & 15, cc = c & 31, ob = rr * 64 + cc * 2; return st * 1024 + (ob ^ (((ob >> 9) & 1) << 5)); }
DI void stage_rc(int b, int& R, int& C) { const int st = b / 1024, sb = b % 1024, swz = sb ^ (((sb >> 9) & 1) << 5); R = (st >> 1) * 16 + swz / 64; C = (st & 1) * 32 + (swz % 64) / 2; }
DI int perm32(int rho) { const int n = rho >> 4, i = rho & 15; return 8 * (i >> 2) + 4 * n + (i & 3); }
struct Unit { int pm, pn; };
struct Gemm { const u16* A; const u16* Bt; int M, N, K, lda, ldb, a_shift, a_colbytes; };
struct StaticOrder {
    int nM, nN, nwg, G, c;
    DI void init(int M_, int N_, int G_, int c_) { nM = M_ / BM; nN = N_ / BM; nwg = nM * nN; G = G_; c = c_; }
    DI bool next(int i, Unit& u) const {
        const long L = (long)i * G + c; if (L >= nwg) return false;
        int wgid = (int)L; { const int q = nwg / NXCD, r = nwg % NXCD, xcd = wgid % NXCD, off = wgid / NXCD; wgid = (xcd < r ? xcd * (q + 1) : r * (q + 1) + (xcd - r) * q) + off; }
        const int nig = WGM * nN, gid = wgid / nig, fm = gid * WGM, gsz = (nM - fm) < WGM ? (nM - fm) : WGM;
        u.pm = fm + ((wgid % nig) % gsz); u.pn = (wgid % nig) / gsz; return true;
    }
};

template <class Epi>
DI void gemm_phase(LAS unsigned char* lds, const Gemm g, const StaticOrder& S, const Epi& E) {
    const int tid = threadIdx.x, wid = __builtin_amdgcn_readfirstlane(tid >> 6), lane = tid & 63, wr = wid >> 2, wc = wid & 3, fr = lane & 15, fq = lane >> 4;
    const int K = g.K, nt = K / BK;
    unsigned voffA[2], voffB[2];
#pragma unroll
    for (int i = 0; i < 2; ++i) { int R, C; stage_rc(tid * 16 + i * 8192, R, C); const int Rb = Epi::PERM ? ((R & ~31) + perm32(R & 31)) : R;
        voffA[i] = (unsigned)(R * g.lda + C) * 2u; voffB[i] = (unsigned)(Rb * g.ldb + C) * 2u; }
    const size_t kstep = (size_t)(BK * 2);
    const size_t hstepA = (size_t)HALF * g.lda * 2, hstepB = (size_t)HALF * g.ldb * 2;
    const unsigned ldsw = (unsigned)wid * 1024u;
    const int aoff = lds_byte(wr * 64 + fr, fq * 8), boff = lds_byte(wc * 32 + fr, fq * 8);
#define PG8_SA(b, h) (((b) * 2 + (h)) * HTB)
#define PG8_SB(b, h) ((4 + (b) * 2 + (h)) * HTB)
#define PG8_STAGE(bufoff, gbase, voff) do { _Pragma("unroll") for (int _i = 0; _i < 2; ++_i) \
        __builtin_amdgcn_global_load_lds((const unsigned*)((const char*)(gbase) + (voff)[_i]), (LAS unsigned*)(lds + (bufoff) + ldsw + _i * 8192), 16, 0, 0); } while (0)
#define PG8_LDA(dst, b, h) do { _Pragma("unroll") for (int m = 0; m < 4; ++m) _Pragma("unroll") for (int k = 0; k < 2; ++k) dst[m][k] = *(const LAS bf16x8*)(lds + PG8_SA(b, h) + aoff + m * 2048 + k * 1024); } while (0)
#define PG8_LDB(dst, b, h) do { _Pragma("unroll") for (int n = 0; n < 2; ++n) _Pragma("unroll") for (int k = 0; k < 2; ++k) dst[n][k] = *(const LAS bf16x8*)(lds + PG8_SB(b, h) + boff + n * 2048 + k * 1024); } while (0)
#define PG8_MMA(ai, bj, At, Bt) do { __builtin_amdgcn_s_setprio(1); _Pragma("unroll") for (int m = 0; m < 4; ++m) _Pragma("unroll") for (int n = 0; n < 2; ++n) _Pragma("unroll") for (int k = 0; k < 2; ++k) \
        acc[ai][bj][m][n] = __builtin_amdgcn_mfma_f32_16x16x32_bf16(Bt[n][k], At[m][k], acc[ai][bj][m][n], 0, 0, 0); __builtin_amdgcn_s_setprio(0); } while (0)
#define PG8_WAIT_V(n) asm volatile("s_waitcnt vmcnt(" #n ")" ::: "memory")
#define PG8_WAIT_L(n) asm volatile("s_waitcnt lgkmcnt(" #n ")" ::: "memory")
#define PG8_BAR __builtin_amdgcn_s_barrier()
#define PG8_SCHED __builtin_amdgcn_sched_barrier(0)
#define PG8_APTR(u) ((const char*)g.A + (size_t)(u).pm * 2 * hstepA + (size_t)((u).pn >> g.a_shift) * g.a_colbytes)
#define PG8_BPTR(u) ((const char*)g.Bt + (size_t)(u).pn * 2 * hstepB)
    Unit cur, nxt; int ui = 0;
    if (!S.next(0, cur)) return;
    f32x4 acc[2][2][4][2];
#pragma unroll
    for (int a = 0; a < 2; ++a)
#pragma unroll
        for (int b = 0; b < 2; ++b)
#pragma unroll
            for (int m = 0; m < 4; ++m)
#pragma unroll
                for (int n = 0; n < 2; ++n) acc[a][b][m][n] = (f32x4){0.f, 0.f, 0.f, 0.f};
    bf16x8 At[4][2], B0[2][2], B1[2][2];
    const char* cA = PG8_APTR(cur); const char* cB = PG8_BPTR(cur);
    PG8_STAGE(PG8_SB(0, 0), cB, voffB); PG8_STAGE(PG8_SA(0, 0), cA, voffA); PG8_STAGE(PG8_SB(0, 1), cB + hstepB, voffB); PG8_STAGE(PG8_SA(0, 1), cA + hstepA, voffA);
    if (wr == 1) PG8_BAR;
    PG8_WAIT_V(4); PG8_BAR;
    PG8_STAGE(PG8_SB(1, 0), cB + kstep, voffB); PG8_STAGE(PG8_SA(1, 0), cA + kstep, voffA); PG8_STAGE(PG8_SB(1, 1), cB + hstepB + kstep, voffB);
    PG8_WAIT_V(6); PG8_BAR;
    for (;;) {
        const bool has_next = S.next(ui + 1, nxt);
        const char* nA = has_next ? PG8_APTR(nxt) : cA; const char* nB = has_next ? PG8_BPTR(nxt) : cB;
        for (int t = 0; t < nt; t += 2) {
            const bool last = (t == nt - 2);
            const char* a1 = cA + (size_t)(t + 1) * kstep;
            const char* a2 = last ? nA : cA + (size_t)(t + 2) * kstep; const char* b2 = last ? nB : cB + (size_t)(t + 2) * kstep;
            const char* a3 = a2 + kstep; const char* b3 = b2 + kstep;
            PG8_LDB(B0, 0, 0); PG8_SCHED; PG8_LDA(At, 0, 0); PG8_STAGE(PG8_SA(1, 1), a1 + hstepA, voffA);
            PG8_WAIT_L(8); PG8_BAR; PG8_WAIT_L(0); PG8_MMA(0, 0, At, B0); PG8_BAR; PG8_SCHED;
            PG8_LDB(B1, 0, 1); PG8_STAGE(PG8_SB(0, 0), b2, voffB);
            PG8_BAR; PG8_WAIT_L(0); PG8_MMA(0, 1, At, B1); PG8_BAR;
            PG8_LDA(At, 0, 1); PG8_STAGE(PG8_SA(0, 0), a2, voffA);
            PG8_BAR; PG8_WAIT_L(0); PG8_MMA(1, 0, At, B0); PG8_BAR; PG8_SCHED;
            PG8_STAGE(PG8_SB(0, 1), b2 + hstepB, voffB);
            PG8_WAIT_V(6); PG8_BAR; PG8_MMA(1, 1, At, B1); PG8_BAR;
            PG8_LDB(B0, 1, 0); PG8_SCHED; PG8_LDA(At, 1, 0); PG8_STAGE(PG8_SA(0, 1), a2 + hstepA, voffA);
            PG8_WAIT_L(8); PG8_BAR; PG8_WAIT_L(0); PG8_MMA(0, 0, At, B0); PG8_BAR; PG8_SCHED;
            PG8_LDB(B1, 1, 1); PG8_STAGE(PG8_SB(1, 0), b3, voffB);
            PG8_BAR; PG8_WAIT_L(0); PG8_MMA(0, 1, At, B1); PG8_BAR;
            PG8_LDA(At, 1, 1); PG8_STAGE(PG8_SA(1, 0), a3, voffA);
            PG8_BAR; PG8_WAIT_L(0); PG8_MMA(1, 0, At, B0); PG8_BAR; PG8_SCHED;
            PG8_STAGE(PG8_SB(1, 1), b3 + hstepB, voffB);
            PG8_WAIT_V(6); PG8_BAR; PG8_MMA(1, 1, At, B1); PG8_BAR;
        }
        E(acc, cur, wr, wc, fr, fq);
        if (!has_next) break;
#pragma unroll
        for (int a = 0; a < 2; ++a)
#pragma unroll
            for (int b = 0; b < 2; ++b)
#pragma unroll
                for (int m = 0; m < 4; ++m)
#pragma unroll
                    for (int n = 0; n < 2; ++n) acc[a][b][m][n] = (f32x4){0.f, 0.f, 0.f, 0.f};
        cur = nxt; cA = nA; cB = nB; ++ui;
    }
    PG8_WAIT_V(0);
    if (wr == 0) PG8_BAR;
    PG8_BAR;
#undef PG8_SA
#undef PG8_SB
#undef PG8_STAGE
#undef PG8_LDA
#undef PG8_LDB
#undef PG8_MMA
#undef PG8_WAIT_V
#undef PG8_WAIT_L
#undef PG8_BAR
#undef PG8_SCHED
#undef PG8_APTR
#undef PG8_BPTR
}
}
using pg8::Unit;

struct EpiBf16Split {
    static constexpr bool PERM = true;
    u16* base[3]; int split_tiles; int ldc; float* lr; int lr_tile;
    int row_base = 0;
    DI void operator()(const f32x4 (&acc)[2][2][4][2], const Unit& u, int wr, int wc, int fr, int fq) const {
        const int row0 = row_base + u.pm * 256 + wr * 64 + fr;
        if (u.pn == lr_tile) {
            if (wc == 0) {
#pragma unroll
                for (int ai = 0; ai < 2; ++ai)
#pragma unroll
                    for (int m = 0; m < 4; ++m) { float* rp = lr + (size_t)(row0 + ai * 128 + m * 16) * 32 + 8 * fq;
                        *(f32x4*)(rp) = acc[ai][0][m][0]; *(f32x4*)(rp + 4) = acc[ai][0][m][1]; }
            }
            return;
        }
        const int t = u.pn / split_tiles; u16* b = t == 0 ? base[0] : (t == 1 ? base[1] : base[2]);
        const int col0 = (u.pn - t * split_tiles) * 256 + wc * 32 + 8 * fq;
#pragma unroll
        for (int ai = 0; ai < 2; ++ai)
#pragma unroll
            for (int m = 0; m < 4; ++m) { u16* rowp = b + (size_t)(row0 + ai * 128 + m * 16) * ldc + col0;
#pragma unroll
                for (int bj = 0; bj < 2; ++bj) { const f32x4 v0 = acc[ai][bj][m][0], v1 = acc[ai][bj][m][1];
                    u32x4 w; w.x = pk2(v0[0], v0[1]); w.y = pk2(v0[2], v0[3]); w.z = pk2(v1[0], v1[1]); w.w = pk2(v1[2], v1[3]);
                    *(u32x4*)(rowp + bj * 128) = w; } }
    }
};
struct EpiPair {
    static constexpr bool PERM = true;
    unsigned* GA;
    DI void operator()(const f32x4 (&acc)[2][2][4][2], const Unit& u, int wr, int wc, int fr, int fq) const {
        const int blk = u.pn >> 2, dir = (u.pn >> 1) & 1, half = u.pn & 1;
        const int row0 = u.pm * 256 + wr * 64 + fr;
        unsigned* ga = GA + (size_t)dir * M * LW + blk * 256 + half * 128 + wc * 32 + 8 * fq;
#pragma unroll
        for (int ai = 0; ai < 2; ++ai)
#pragma unroll
            for (int m = 0; m < 4; ++m) { unsigned* rp = ga + (size_t)(row0 + ai * 128 + m * 16) * LW;
#pragma unroll
                for (int n = 0; n < 2; ++n) { u32x4 w;
#pragma unroll
                    for (int j = 0; j < 4; ++j) w[j] = pk2(acc[ai][0][m][n][j], acc[ai][1][m][n][j]);
                    *(u32x4*)(rp + 4 * n) = w; } }
    }
};
DI void gate_au(unsigned w, float z, float ba, float bx, float c8, float& a, float& u) {
    const float r = sigmoid_f(lo_bf(w) + ba), ig = sigmoid_f(hi_bf(w) + bx);
    a = fexp(-c8 * r); u = __builtin_amdgcn_sqrtf(fmaxf(1.f - a * a, 0.f)) * ig * z;
}

DI void phase_prep(const Params& p, unsigned char* shm) {
    const int tid = threadIdx.x;
    float* scS = (float*)shm;
    float* red = scS + 5 * 1024;
    float* MOD = (float*)(p.ws + OFF_MOD);
    for (int i = tid; i < 5 * 1024; i += 512) { const int v = i >> 10, k = i & 1023; const float cv = v < 4 ? p.in[1][v * 1024 + k] : p.in[3][k]; scS[i] = silu_f(cv); }
    __syncthreads();
    for (int item = blockIdx.x; item < 192; item += gridDim.x) {
        const int layer = item / 96, n0 = (item % 96) * 32, col = tid & 31, kg = tid >> 5;
        float a0 = 0.f, a1 = 0.f, a2 = 0.f, a3 = 0.f, a4 = 0.f;
        const float* w = p.in[4] + (size_t)layer * 1024 * 3072 + n0 + col;
#pragma unroll 16
        for (int kk = 0; kk < 64; ++kk) { const int k = kg * 64 + kk; const float wv = ntload(w + (size_t)k * 3072);
            a0 += scS[k] * wv; a1 += scS[1024 + k] * wv; a2 += scS[2048 + k] * wv; a3 += scS[3072 + k] * wv; a4 += scS[4096 + k] * wv; }
        red[(kg * 5 + 0) * 32 + col] = a0; red[(kg * 5 + 1) * 32 + col] = a1; red[(kg * 5 + 2) * 32 + col] = a2; red[(kg * 5 + 3) * 32 + col] = a3; red[(kg * 5 + 4) * 32 + col] = a4;
        __syncthreads();
        if (tid < 160) { const int v = tid >> 5, c2 = tid & 31; float s = 0.f;
#pragma unroll
            for (int q = 0; q < 16; ++q) s += red[(q * 5 + v) * 32 + c2];
            MOD[(layer * 5 + v) * 3072 + n0 + c2] = s + p.in[5][layer * 3072 + n0 + c2]; }
        __syncthreads();
    }
}
DI void phase_transposes(const Params& p, unsigned char* shm, int wgi, int nwg) {
    const int tid = threadIdx.x;
    float* tile = (float*)shm;
    constexpr int T0 = 16 * 49, T1 = T0 + 256, T2 = T1 + 640, T3 = T2 + 320, T4 = T3 + 320;
    for (int tb = wgi; tb < T4; tb += 4 * nwg) {
        const float* src[4]; u16* dst[4]; int sld[4], dld[4], Nn[4], k0[4], n0[4]; bool valid[4];
#pragma unroll
        for (int u = 0; u < 4; ++u) {
            const int tl = tb + u * nwg; valid[u] = tl < T4; const int tc = valid[u] ? tl : 0; int kt, ntl;
            if (tc < T0) { kt = tc / 49; ntl = tc % 49; src[u] = p.in[8]; sld[u] = 3104; Nn[u] = 3104; dst[u] = (u16*)(p.ws + OFF_WT1); dld[u] = 1024; }
            else if (tc < T1) { const int t = tc - T0; kt = t / 16; ntl = t % 16; src[u] = p.in[14]; sld[u] = 1024; Nn[u] = 1024; dst[u] = (u16*)(p.ws + OFF_WT2); dld[u] = 1024; }
            else if (tc < T2) { const int t = tc - T1; kt = t / 40; ntl = t % 40; src[u] = p.in[15]; sld[u] = 2560; Nn[u] = 2560; dst[u] = (u16*)(p.ws + OFF_WT3); dld[u] = 1024; }
            else if (tc < T3) { const int t = tc - T2; kt = t / 16; ntl = t % 16; src[u] = p.in[28]; sld[u] = 1024; Nn[u] = 1024; dst[u] = (u16*)(p.ws + OFF_WT5); dld[u] = 1280; }
            else { const int t = tc - T3; const int j = t >> 3, tt = t & 7; kt = tt >> 1; ntl = tt & 1;
                const int gate = j / 10, rem = j % 10, blk = rem >> 1, half = rem & 1, dir = gate >> 1, isx = gate & 1;
                const float* gp = gate == 0 ? p.in[18] : (gate == 1 ? p.in[20] : (gate == 2 ? p.in[23] : p.in[25]));
                src[u] = gp + blk * 65536 + half * 128; sld[u] = 256; Nn[u] = 128;
                dst[u] = (u16*)(p.ws + OFF_WT4) + (size_t)((blk * 4 + dir * 2 + half) * 256 + isx * 128) * 256; dld[u] = 256; }
            k0[u] = kt * 64; n0[u] = ntl * 64;
        }
        float v[4][8];
#pragma unroll
        for (int u = 0; u < 4; ++u)
#pragma unroll
            for (int i = 0; i < 8; ++i) { const int e = tid + i * 512, kr = e >> 6, nc = e & 63;
                v[u][i] = (n0[u] + nc < Nn[u]) ? ntload(src[u] + (size_t)(k0[u] + kr) * sld[u] + n0[u] + nc) : 0.f; }
        __syncthreads();
#pragma unroll
        for (int u = 0; u < 4; ++u)
#pragma unroll
            for (int i = 0; i < 8; ++i) { const int e = tid + i * 512, kr = e >> 6, nc = e & 63; tile[u * 4160 + kr * 65 + nc] = v[u][i]; }
        __syncthreads();
#pragma unroll
        for (int u = 0; u < 4; ++u) if (valid[u]) {
#pragma unroll
            for (int i = 0; i < 4; ++i) { const int pi = tid + i * 512, nr = pi >> 5, kc = (pi & 31) * 2;
                if (n0[u] + nr < Nn[u]) *(unsigned*)(dst[u] + (size_t)(n0[u] + nr) * dld[u] + k0[u] + kc) = pk2(tile[u * 4160 + kc * 65 + nr], tile[u * 4160 + (kc + 1) * 65 + nr]); } }
    }
}

DI const float* row_src(const Params& p, int row) { return row < MX ? p.in[0] + (size_t)row * D : p.in[2] + (size_t)(row - MX) * D; }
DI int row_perm(int row) { if (row >= MX) return row; const int b = row >> 13, t = row & 8191; return (b << 13) + (t & 63) * 128 + (t >> 6); }

DI void phase_h0(const Params& p, int wgi, int nwg) {
    const int wave = threadIdx.x >> 6, lane = threadIdx.x & 63;
    const float* MOD = (const float*)(p.ws + OFF_MOD);
    u16* H = (u16*)(p.ws + OFF_R0);
    for (int row = wgi * 16 + wave * 2; row < M; row += nwg * 16) {
        const int vec = row < MX ? row >> 13 : 4;
        const float* mod = MOD + (size_t)vec * 3072;
        f32x4 v[2][4]; float ss[2] = {0.f, 0.f};
#pragma unroll
        for (int r = 0; r < 2; ++r) { const float* src = row_src(p, row + r);
#pragma unroll
            for (int i = 0; i < 4; ++i) v[r][i] = ntload((const f32x4*)(src + i * 256 + lane * 4)); }
#pragma unroll
        for (int r = 0; r < 2; ++r) {
#pragma unroll
            for (int i = 0; i < 4; ++i) ss[r] += v[r][i][0] * v[r][i][0] + v[r][i][1] * v[r][i][1] + v[r][i][2] * v[r][i][2] + v[r][i][3] * v[r][i][3];
            ss[r] = rsqrtf(wave_sum(ss[r]) * (1.f / 1024.f) + 1e-6f); }
#pragma unroll
        for (int i = 0; i < 4; ++i) { const int c = i * 256 + lane * 4;
            const f32x4 g = *(const f32x4*)(p.in[6] + c), sh = *(const f32x4*)(mod + c), sc = *(const f32x4*)(mod + 1024 + c);
#pragma unroll
            for (int r = 0; r < 2; ++r) { float o[4];
#pragma unroll
                for (int j = 0; j < 4; ++j) o[j] = v[r][i][j] * ss[r] * g[j] * (1.f + sc[j]) + sh[j];
                u32x2 w; w.x = pk2(o[0], o[1]); w.y = pk2(o[2], o[3]); *(u32x2*)(H + (size_t)(row + r) * D + c) = w; } }
    }
}

DI void phase_gla_chunk(const Params& p, unsigned char* shm, float* outbuf) {
    const int tid = threadIdx.x, wave = tid >> 6, lane = tid & 63, l15 = lane & 15, lg4 = lane >> 4;
    float* lrS = (float*)shm;
    float* wgS = lrS + 64 * 32;
    float* bgS = wgS + 2 * 16 * 128;
    float* totS = bgS + 256;
    u16* qtS = (u16*)(totS + 512);
    u16* kbS = qtS + 64 * 136;
    u16* PS = kbS + 64 * 136;
    u16* vTS = PS + 64 * 72;
    u16* ktS = vTS + 256 * 72;
    const float* LR = (const float*)(p.ws + OFF_LR);
    const u16* QK = (const u16*)(p.ws + OFF_R1);
    const u16* V = (const u16*)(p.ws + OFF_R2);
    u16* QX = (u16*)(p.ws + OFF_R4);
    u16* KT = (u16*)outbuf;
    u16* VT = (u16*)(p.ws + OFF_VT);
    float* EL = (float*)(p.ws + OFF_EL);
    u16* OINTRA = (u16*)(p.ws + OFF_R0);
    int h_loaded = -1;
    for (int item = blockIdx.x; item < NCH * 4; item += gridDim.x) {
        const int cidx = item >> 2, h = item & 3, row0 = cidx * 64;
        u16 qraw[16], kraw[16], vraw[32]; float lrv[4];
        { const u16* qp = QK + (size_t)(row0 + (tid >> 7) * 16) * D + h * 128 + (tid & 127);
#pragma unroll
          for (int tt = 0; tt < 16; ++tt) { qraw[tt] = ntload(qp + (size_t)tt * D); kraw[tt] = ntload(qp + (size_t)tt * D + 512); }
          const u16* vp = V + (size_t)(row0 + (tid >> 8) * 32) * D + h * 256 + (tid & 255);
#pragma unroll
          for (int t2 = 0; t2 < 32; ++t2) vraw[t2] = ntload(vp + (size_t)t2 * D);
#pragma unroll
          for (int i = 0; i < 4; ++i) lrv[i] = ntload(LR + (size_t)row0 * 32 + tid + i * 512); }
        if (h != h_loaded) {
            float wv[8]; float bv = 0.f;
#pragma unroll
            for (int i = 0; i < 8; ++i) { const int e = tid + i * 512, d = e >> 11, r = (e >> 7) & 15, k = e & 127; wv[i] = (d ? p.in[11] : p.in[9])[r * 512 + h * 128 + k]; }
            if (tid < 256) { const int d = tid >> 7, k = tid & 127; bv = (d ? p.in[12] : p.in[10])[h * 128 + k]; }
#pragma unroll
            for (int i = 0; i < 8; ++i) wgS[tid + i * 512] = wv[i];
            if (tid < 256) bgS[tid] = bv;
            h_loaded = h;
        }
#pragma unroll
        for (int i = 0; i < 4; ++i) lrS[tid + i * 512] = lrv[i];
        {
            const int v = tid & 255, th = tid >> 8;
            unsigned pw[16];
#pragma unroll
            for (int t2 = 0; t2 < 16; ++t2) pw[t2] = (unsigned)vraw[2 * t2] | ((unsigned)vraw[2 * t2 + 1] << 16);
#pragma unroll
            for (int q = 0; q < 4; ++q) { const u32x4 w = {pw[4 * q], pw[4 * q + 1], pw[4 * q + 2], pw[4 * q + 3]};
                *(u32x4*)(vTS + v * 72 + th * 32 + q * 8) = w; }
        }
        __syncthreads();
        {
            u16* g = VT + (size_t)(cidx * 4 + h) * 16384;
#pragma unroll
            for (int j = 0; j < 4; ++j) { const int id = tid + j * 512; *(u32x4*)(g + id * 8) = *(const u32x4*)(vTS + (id >> 3) * 72 + (id & 7) * 8); }
        }
        f32x4 pacc[2] = {{0.f, 0.f, 0.f, 0.f}, {0.f, 0.f, 0.f, 0.f}};
#pragma unroll
        for (int dir = 0; dir < 2; ++dir) {
            const int k = tid & 127, tg = tid >> 7;
            float wreg[16];
#pragma unroll
            for (int r = 0; r < 16; ++r) wreg[r] = wgS[(dir * 16 + r) * 128 + k];
            const float bgv = bgS[dir * 128 + k];
            float lg[16];
#pragma unroll
            for (int tt = 0; tt < 16; ++tt) { const int t = tg * 16 + tt; float z = bgv;
#pragma unroll
                for (int r = 0; r < 16; ++r) z += lrS[t * 32 + dir * 16 + r] * wreg[r];
                lg[tt] = -(fmaxf(-z, 0.f) + flog(1.f + fexp(-fabsf(z)))) * (1.f / 16.f); }
            float run = 0.f;
            if (dir == 0) {
#pragma unroll
                for (int tt = 0; tt < 16; ++tt) { run += lg[tt]; lg[tt] = run; }
            } else {
#pragma unroll
                for (int tt = 15; tt >= 0; --tt) { run += lg[tt]; lg[tt] = run; }
            }
            totS[tg * 128 + k] = run;
            __syncthreads();
            float off = 0.f, total = 0.f;
#pragma unroll
            for (int g2 = 0; g2 < 4; ++g2) { const float tv = totS[g2 * 128 + k]; total += tv; if (dir == 0 ? (g2 < tg) : (g2 > tg)) off += tv; }
            unsigned kh[8];
            u16* qx = QX + (size_t)dir * M * 512;
#pragma unroll
            for (int t2 = 0; t2 < 8; ++t2) {
                float khv[2];
#pragma unroll
                for (int e = 0; e < 2; ++e) { const int tt = 2 * t2 + e, t = tg * 16 + tt;
                    const float cum = lg[tt] + off;
                    const float qv = bf2f(qraw[tt]) * 0.08838834764831845f;
                    const float kv = bf2f(kraw[tt]);
                    const u16 qt = f2bf(qv * fexp(cum));
                    qtS[t * 136 + k] = qt;
                    kbS[t * 136 + k] = f2bf(kv * fexp(-cum));
                    khv[e] = kv * fexp(total - cum); }
                kh[t2] = pk2(khv[0], khv[1]);
            }
            { const u32x4 w0 = {kh[0], kh[1], kh[2], kh[3]}, w1 = {kh[4], kh[5], kh[6], kh[7]};
              *(u32x4*)(ktS + k * 72 + tg * 16) = w0; *(u32x4*)(ktS + k * 72 + tg * 16 + 8) = w1; }
            if (tg == 0) EL[((size_t)dir * NCH + cidx) * 512 + h * 128 + k] = fexp(total);
            __syncthreads();
            {
#pragma unroll
                for (int j = 0; j < 2; ++j) { const int id = tid + j * 512;
                    { const int t_ = id >> 4, pc = id & 15, ks_ = pc >> 2, d_ = pc & 3;
                      const u32x2 lo = *(const u32x2*)(qtS + t_ * 136 + ks_ * 32 + 4 * d_), hi = *(const u32x2*)(qtS + t_ * 136 + ks_ * 32 + 16 + 4 * d_);
                      const u32x4 w = {lo.x, lo.y, hi.x, hi.y};
                      *(u32x4*)(qx + (size_t)(row0 + t_) * 512 + h * 128 + pc * 8) = w; }
                    *(u32x4*)(KT + (((size_t)dir * NCH + cidx) * 4 + h) * 8192 + id * 8) = *(const u32x4*)(ktS + (id >> 3) * 72 + (id & 7) * 8); }
            }
#pragma unroll
            for (int x = 0; x < 2; ++x) { const int id = wave * 2 + x, it = id >> 2, jt = id & 3;
                if (dir == 0 ? (jt <= it) : (jt >= it)) {
                    f32x4 a4 = {0.f, 0.f, 0.f, 0.f};
#pragma unroll
                    for (int ks = 0; ks < 4; ++ks) { const bf16x8 a = *(const bf16x8*)(qtS + (it * 16 + l15) * 136 + ks * 32 + lg4 * 8);
                        const bf16x8 b = *(const bf16x8*)(kbS + (jt * 16 + l15) * 136 + ks * 32 + lg4 * 8);
                        a4 = __builtin_amdgcn_mfma_f32_16x16x32_bf16(a, b, a4, 0, 0, 0); }
#pragma unroll
                    for (int r = 0; r < 4; ++r) { const int i = it * 16 + lg4 * 4 + r, j = jt * 16 + l15;
                        const bool keep = dir == 0 ? (j <= i) : (j >= i); pacc[x][r] += keep ? a4[r] : 0.f; }
                }
            }
            __syncthreads();
        }
#pragma unroll
        for (int x = 0; x < 2; ++x) { const int id = wave * 2 + x, it = id >> 2, jt = id & 3;
#pragma unroll
            for (int r = 0; r < 4; ++r) PS[(it * 16 + lg4 * 4 + r) * 72 + jt * 16 + l15] = f2bf(pacc[x][r]); }
        __syncthreads();
#pragma unroll
        for (int x = 0; x < 2; ++x) { const int vt = wave * 2 + x;
            const bf16x8 av0 = *(const bf16x8*)(vTS + (vt * 16 + l15) * 72 + lg4 * 8), av1 = *(const bf16x8*)(vTS + (vt * 16 + l15) * 72 + 32 + lg4 * 8);
#pragma unroll
            for (int it = 0; it < 4; ++it) {
                const bf16x8 b0 = *(const bf16x8*)(PS + (it * 16 + l15) * 72 + lg4 * 8), b1 = *(const bf16x8*)(PS + (it * 16 + l15) * 72 + 32 + lg4 * 8);
                f32x4 a4 = {0.f, 0.f, 0.f, 0.f};
                a4 = __builtin_amdgcn_mfma_f32_16x16x32_bf16(av0, b0, a4, 0, 0, 0);
                a4 = __builtin_amdgcn_mfma_f32_16x16x32_bf16(av1, b1, a4, 0, 0, 0);
                u32x2 w; w.x = pk2(a4[0], a4[1]); w.y = pk2(a4[2], a4[3]);
                *(u32x2*)(OINTRA + (size_t)(row0 + it * 16 + l15) * D + h * 256 + vt * 16 + lg4 * 4) = w; }
        }
        __syncthreads();
    }
}

template <int MODE> DI void phase_gla_seq(const Params& p, unsigned char* shm, const float* outbuf) {
    const int tid = threadIdx.x, wave = __builtin_amdgcn_readfirstlane(tid >> 6), lane = tid & 63, l15 = lane & 15, lg4 = lane >> 4;
    constexpr int QS_B = 64 * 288, KS_B = 128 * 144, VS_B = 32 * 144, BUF_B = QS_B + KS_B + VS_B + 512;
    constexpr int SF_OFF = 2 * BUF_B, SF_B = 8192;
    const u16* VT = (const u16*)(p.ws + OFF_VT);
    const float* ELb = (const float*)(p.ws + OFF_EL);
#define SEQ_BAR() do { __builtin_amdgcn_fence(__ATOMIC_RELEASE, "workgroup"); __builtin_amdgcn_s_barrier(); __builtin_amdgcn_fence(__ATOMIC_ACQUIRE, "workgroup"); } while (0)
    for (int item0 = blockIdx.x; item0 < 256; item0 += gridDim.x) {
        const int item = (((item0 & 7) * 4 + (item0 >> 6)) << 3) | ((item0 >> 3) & 7);
        const int vs = item & 7, dir = (item >> 3) & 1, h = (item >> 4) & 3, b = item >> 6;
        const unsigned char* QX = (const unsigned char*)((const u16*)(p.ws + OFF_R4) + (size_t)dir * M * 512 + h * 128);
        const unsigned char* KT = (const unsigned char*)((const u16*)outbuf + (size_t)dir * NCH * 4 * 8192 + (size_t)h * 8192);
        const unsigned char* VTb = (const unsigned char*)(VT + (size_t)h * 16384 + vs * 32 * 64);
        const unsigned char* EL = (const unsigned char*)(ELb + (size_t)dir * NCH * 512 + h * 128);
        u16* OI = (u16*)(p.ws + (dir ? OFF_R2 : OFF_R1));
#define SEQ_CIDX(s) ((s) < 4 ? 512 + 4 * b + (dir ? 3 - (s) : (s)) : 128 * b + (dir ? 127 - ((s) - 4) : ((s) - 4)))
        __syncthreads();
        *(u32x4*)(shm + SF_OFF + tid * 16) = (u32x4){0u, 0u, 0u, 0u};
        if (wave >= 4) {
            const int lt = tid - 256;
            unsigned soff[10], doff[10]; int kind[10];
#pragma unroll
            for (int i = 0; i < 10; ++i) { int id = lt + i * 256; if (id > 2335) id = 2335;
                if (id < 1024) { kind[i] = 0; soff[i] = (unsigned)((id >> 4) * 1024 + (id & 15) * 16); doff[i] = (unsigned)((id >> 4) * 288 + (id & 15) * 16); }
                else if (id < 2048) { const int j = id - 1024; kind[i] = 1; soff[i] = (unsigned)(j * 16); doff[i] = (unsigned)(QS_B + (j >> 3) * 144 + (j & 7) * 16); }
                else if (id < 2304) { const int j = id - 2048; kind[i] = 2; soff[i] = (unsigned)(j * 16); doff[i] = (unsigned)(QS_B + KS_B + (j >> 3) * 144 + (j & 7) * 16); }
                else { const int j = id - 2304; kind[i] = 3; soff[i] = (unsigned)(j * 16); doff[i] = (unsigned)(QS_B + KS_B + VS_B + j * 16); } }
            const bool last_valid = (lt + 9 * 256) < 2336;
            u32x4 ra[10], rb[10], rc[10], rd[10];
#define SEQ_LOAD(R, s) do { const int sl_ = (s) < 132 ? (s) : 131; const int ci = SEQ_CIDX(sl_); \
                const unsigned char* b0 = QX + (size_t)ci * 65536; const unsigned char* b1 = KT + (size_t)ci * 65536; \
                const unsigned char* b2 = VTb + (size_t)ci * 131072; const unsigned char* b3 = EL + (size_t)ci * 2048; \
                _Pragma("unroll") for (int i = 0; i < 10; ++i) { const unsigned char* bp = kind[i] == 0 ? b0 : (kind[i] == 1 ? b1 : (kind[i] == 2 ? b2 : b3)); \
                    if (i == 8) R[i] = ntload((const u32x4*)(bp + soff[i]));   \
                    else R[i] = *(const u32x4*)(bp + soff[i]); } } while (0)
#define SEQ_STORE(R, bi) do { unsigned char* bb = shm + (bi) * BUF_B; \
                _Pragma("unroll") for (int i = 0; i < 9; ++i) *(u32x4*)(bb + doff[i]) = R[i]; \
                *(u32x4*)(last_valid ? bb + doff[9] : shm + SF_OFF + 2 * SF_B + lt * 16) = R[9]; } while (0)
#define SEQ_STEP(R, s) do { if ((s) + 1 < 132) SEQ_STORE(R, ((s) + 1) & 1); SEQ_LOAD(R, (s) + 5); SEQ_BAR(); } while (0)
            SEQ_LOAD(ra, 0); SEQ_STORE(ra, 0);
            SEQ_LOAD(ra, 1); SEQ_LOAD(rb, 2); SEQ_LOAD(rc, 3); SEQ_LOAD(rd, 4);
            SEQ_BAR();
            for (int s = 0; s < 132; s += 4) { SEQ_STEP(ra, s); SEQ_STEP(rb, s + 1); SEQ_STEP(rc, s + 2); SEQ_STEP(rd, s + 3); }
#undef SEQ_LOAD
#undef SEQ_STORE
#undef SEQ_STEP
        } else if (wave < 2) {
            f32x4 S[8];
#pragma unroll
            for (int i = 0; i < 8; ++i) S[i] = (f32x4){0.f, 0.f, 0.f, 0.f};
            SEQ_BAR();
            for (int s = 0; s < 132; ++s) {
                const unsigned char* bb = shm + (s & 1) * BUF_B;
                bf16x8 ka[8][2], vb[2]; f32x4 el[8];
#pragma unroll
                for (int ts = 0; ts < 2; ++ts) { vb[ts] = *(const bf16x8*)(bb + QS_B + KS_B + (wave * 16 + l15) * 144 + ts * 64 + lg4 * 16);
#pragma unroll
                    for (int kt = 0; kt < 8; ++kt) ka[kt][ts] = *(const bf16x8*)(bb + QS_B + (kt * 16 + l15) * 144 + ts * 64 + lg4 * 16); }
#pragma unroll
                for (int kt = 0; kt < 8; ++kt) el[kt] = *(const f32x4*)(bb + QS_B + KS_B + VS_B + (kt * 16 + lg4 * 4) * 4);
#pragma unroll
                for (int kt = 0; kt < 8; ++kt) S[kt] = S[kt] * el[kt];
#pragma unroll
                for (int ts = 0; ts < 2; ++ts)
#pragma unroll
                    for (int kt = 0; kt < 8; ++kt) S[kt] = __builtin_amdgcn_mfma_f32_16x16x32_bf16(ka[kt][ts], vb[ts], S[kt], 0, 0, 0);
                unsigned char* sfp = shm + SF_OFF + ((s + 1) & 1) * SF_B + wave * 4096 + lane * 16;
#pragma unroll
                for (int ks = 0; ks < 4; ++ks) { u32x4 w; w.x = pk2(S[2 * ks][0], S[2 * ks][1]); w.y = pk2(S[2 * ks][2], S[2 * ks][3]);
                    w.z = pk2(S[2 * ks + 1][0], S[2 * ks + 1][1]); w.w = pk2(S[2 * ks + 1][2], S[2 * ks + 1][3]); *(u32x4*)(sfp + ks * 1024) = w; }
                SEQ_BAR();
            }
        } else {
            const int w2 = wave - 2;
            SEQ_BAR();
            for (int s = 0; s < 132; ++s) {
                const unsigned char* bb = shm + (s & 1) * BUF_B;
                const int cidx = SEQ_CIDX(s);
                const unsigned char* sfp = shm + SF_OFF + (s & 1) * SF_B + w2 * 4096 + lane * 16;
                bf16x8 sf[4]; u32x4 qf[4][4];
#pragma unroll
                for (int ks = 0; ks < 4; ++ks) sf[ks] = *(const bf16x8*)(sfp + ks * 1024);
#pragma unroll
                for (int tt = 0; tt < 4; ++tt)
#pragma unroll
                    for (int ks = 0; ks < 4; ++ks) qf[tt][ks] = *(const u32x4*)(bb + (tt * 16 + l15) * 288 + ks * 64 + lg4 * 16);
                f32x4 a4[4];
#pragma unroll
                for (int tt = 0; tt < 4; ++tt) a4[tt] = (f32x4){0.f, 0.f, 0.f, 0.f};
#pragma unroll
                for (int ks = 0; ks < 4; ++ks)
#pragma unroll
                    for (int tt = 0; tt < 4; ++tt) a4[tt] = __builtin_amdgcn_mfma_f32_16x16x32_bf16(sf[ks], __builtin_bit_cast(bf16x8, qf[tt][ks]), a4[tt], 0, 0, 0);
#pragma unroll
                for (int tt = 0; tt < 4; ++tt) { u32x2 w; w.x = pk2(a4[tt][0], a4[tt][1]); w.y = pk2(a4[tt][2], a4[tt][3]);
                    *(u32x2*)(OI + (size_t)(cidx * 64 + tt * 16 + l15) * D + h * 256 + vs * 32 + w2 * 16 + lg4 * 4) = w; }
                SEQ_BAR();
            }
        }
#undef SEQ_CIDX
    }
#undef SEQ_BAR
}

DI void phase_gla_combine(const Params& p, int row_lo, int row_hi, int wgi, int nwg) {
    const int wave = threadIdx.x >> 6, lane = threadIdx.x & 63;
    const u16* O0 = (const u16*)(p.ws + OFF_R0); const u16* O1 = (const u16*)(p.ws + OFF_R1); const u16* O2 = (const u16*)(p.ws + OFF_R2);
    const u16* G = (const u16*)(p.ws + OFF_R3); u16* A2 = (u16*)(p.ws + OFF_R4);
    const int vc = (lane & 31) * 8;
    const f32x4 gn0 = *(const f32x4*)(p.in[13] + vc), gn1 = *(const f32x4*)(p.in[13] + vc + 4);
    const float gn[8] = {gn0[0], gn0[1], gn0[2], gn0[3], gn1[0], gn1[1], gn1[2], gn1[3]};
    for (int row = row_lo + wgi * 16 + wave * 2; row < row_hi; row += nwg * 16) {
        u32x4 a[2][2], b[2][2], c[2][2], g[2][2];
#pragma unroll
        for (int r = 0; r < 2; ++r)
#pragma unroll
            for (int q = 0; q < 2; ++q) { const size_t o = (size_t)(row + r) * D + q * 512 + lane * 8;
                a[r][q] = ntload((const u32x4*)(O0 + o)); b[r][q] = ntload((const u32x4*)(O1 + o)); c[r][q] = ntload((const u32x4*)(O2 + o)); g[r][q] = ntload((const u32x4*)(G + o)); }
#pragma unroll
        for (int r = 0; r < 2; ++r)
#pragma unroll
            for (int q = 0; q < 2; ++q) {
                float v[8]; float ss = 0.f;
#pragma unroll
                for (int j = 0; j < 4; ++j) { v[2 * j] = lo_bf(a[r][q][j]) + lo_bf(b[r][q][j]) + lo_bf(c[r][q][j]); v[2 * j + 1] = hi_bf(a[r][q][j]) + hi_bf(b[r][q][j]) + hi_bf(c[r][q][j]); }
#pragma unroll
                for (int j = 0; j < 8; ++j) ss += v[j] * v[j];
                ss += __shfl_xor(ss, 1); ss += __shfl_xor(ss, 2); ss += __shfl_xor(ss, 4); ss += __shfl_xor(ss, 8); ss += __shfl_xor(ss, 16);
                const float rstd = rsqrtf(ss * (1.f / 256.f) + 1e-6f);
                u32x4 w;
#pragma unroll
                for (int j = 0; j < 4; ++j) { const float g0 = lo_bf(g[r][q][j]), g1 = hi_bf(g[r][q][j]);
                    w[j] = pk2(v[2 * j] * rstd * gn[2 * j] * silu_f(g0), v[2 * j + 1] * rstd * gn[2 * j + 1] * silu_f(g1)); }
                *(u32x4*)(A2 + (size_t)(row + r) * D + q * 512 + lane * 8) = w;
            }
    }
}

DI void phase_h1(const Params& p, int row_lo, int row_hi, int wgi, int nwg) {
    const int wave = threadIdx.x >> 6, lane = threadIdx.x & 63;
    const float* MOD = (const float*)(p.ws + OFF_MOD);
    const u16* Y = (const u16*)(p.ws + OFF_Y);
    u16* H = (u16*)(p.ws + OFF_R0);
    for (int row = row_lo + wgi * 16 + wave * 2; row < row_hi; row += nwg * 16) {
        const int vec = row < MX ? row >> 13 : 4;
        const float* mod0 = MOD + (size_t)vec * 3072; const float* mod1 = MOD + (size_t)(5 + vec) * 3072;
        f32x4 v[2][4]; u32x2 yy[2][4];
#pragma unroll
        for (int r = 0; r < 2; ++r) { const float* src = row_src(p, row + r);
#pragma unroll
            for (int i = 0; i < 4; ++i) { const int c = i * 256 + lane * 4; v[r][i] = ntload((const f32x4*)(src + c)); yy[r][i] = ntload((const u32x2*)(Y + (size_t)(row + r) * D + c)); } }
        float rsy[2], rstd[2];
        f32x4 y[2][4];
#pragma unroll
        for (int r = 0; r < 2; ++r) { float ssy = 0.f;
#pragma unroll
            for (int i = 0; i < 4; ++i) { y[r][i] = (f32x4){lo_bf(yy[r][i].x), hi_bf(yy[r][i].x), lo_bf(yy[r][i].y), hi_bf(yy[r][i].y)};
                ssy += y[r][i][0] * y[r][i][0] + y[r][i][1] * y[r][i][1] + y[r][i][2] * y[r][i][2] + y[r][i][3] * y[r][i][3]; }
            rsy[r] = rsqrtf(wave_sum(ssy) * (1.f / 1024.f) + 1e-6f); }
        float ss[2] = {0.f, 0.f};
#pragma unroll
        for (int i = 0; i < 4; ++i) { const int c = i * 256 + lane * 4;
            const f32x4 np = *(const f32x4*)(p.in[7] + c), gt = *(const f32x4*)(mod0 + 2048 + c);
#pragma unroll
            for (int r = 0; r < 2; ++r)
#pragma unroll
                for (int j = 0; j < 4; ++j) { v[r][i][j] += gt[j] * (y[r][i][j] * rsy[r] * np[j]); ss[r] += v[r][i][j] * v[r][i][j]; } }
#pragma unroll
        for (int r = 0; r < 2; ++r) rstd[r] = rsqrtf(wave_sum(ss[r]) * (1.f / 1024.f) + 1e-6f);
#pragma unroll
        for (int i = 0; i < 4; ++i) { const int c = i * 256 + lane * 4;
            const f32x4 g = *(const f32x4*)(p.in[6] + 1024 + c), sh = *(const f32x4*)(mod1 + c), sc = *(const f32x4*)(mod1 + 1024 + c);
#pragma unroll
            for (int r = 0; r < 2; ++r) { float o[4];
#pragma unroll
                for (int j = 0; j < 4; ++j) o[j] = v[r][i][j] * rstd[r] * g[j] * (1.f + sc[j]) + sh[j];
                u32x2 w; w.x = pk2(o[0], o[1]); w.y = pk2(o[2], o[3]); *(u32x2*)(H + (size_t)row_perm(row + r) * D + c) = w; } }
    }
}

DI void phase_conv(const Params& p, float* outbuf) {
    const u16* Z = (const u16*)(p.ws + OFF_Z); u16* ZC = (u16*)outbuf;
    const float* cw = p.in[16]; const float* cb = p.in[17];
    const int total = (M / 8) * 160;
    for (int idx = blockIdx.x * 512 + threadIdx.x; idx < total; idx += gridDim.x * 512) {
        const int row0 = (idx / 160) * 8, ch = (idx % 160) * 8;
        const int pos0 = row0 < MX ? (row0 & 8191) : ((row0 - MX) & 255), len = row0 < MX ? 8192 : 256;
        u32x4 z[11];
#pragma unroll
        for (int i = 0; i < 11; ++i) { const int pp = pos0 + i - 2;
            z[i] = (pp >= 0 && pp < len) ? ntload((const u32x4*)(Z + (size_t)(row0 + i - 2) * LW + ch)) : (u32x4){0u, 0u, 0u, 0u}; }
        f32x4 w[4][2], bias[2];
#pragma unroll
        for (int j = 0; j < 4; ++j) { w[j][0] = *(const f32x4*)(cw + j * LW + ch); w[j][1] = *(const f32x4*)(cw + j * LW + ch + 4); }
        bias[0] = *(const f32x4*)(cb + ch); bias[1] = *(const f32x4*)(cb + ch + 4);
#pragma unroll
        for (int r = 0; r < 8; ++r) {
            f32x4 a0 = bias[0], a1 = bias[1];
#pragma unroll
            for (int j = 0; j < 4; ++j) { const u32x4 zz = z[r + j];
                a0[0] += w[j][0][0] * lo_bf(zz.x); a0[1] += w[j][0][1] * hi_bf(zz.x); a0[2] += w[j][0][2] * lo_bf(zz.y); a0[3] += w[j][0][3] * hi_bf(zz.y);
                a1[0] += w[j][1][0] * lo_bf(zz.z); a1[1] += w[j][1][1] * hi_bf(zz.z); a1[2] += w[j][1][2] * lo_bf(zz.w); a1[3] += w[j][1][3] * hi_bf(zz.w); }
            const u32x4 o = {pk2(a0[0], a0[1]), pk2(a0[2], a0[3]), pk2(a1[0], a1[1]), pk2(a1[2], a1[3])};
            *(u32x4*)(ZC + (size_t)(row0 + r) * LW + ch) = o;
        }
    }
}

DI void phase_lru_agg(const Params& p, const float* outbuf) {
    const unsigned* GAf = (const unsigned*)(p.ws + OFF_AU); const unsigned* GAb = GAf + (size_t)M * LW;
    const u16* ZC = (const u16*)outbuf;
    float* CA = (float*)(p.ws + OFF_CA); float* CU = (float*)(p.ws + OFF_CU);
    const int total = NCH * 320 * 2;
    for (int idx = blockIdx.x * 512 + threadIdx.x; idx < total; idx += gridDim.x * 512) {
        const int half = idx & 1, i2 = idx >> 1, c4 = i2 % 320, cidx = i2 / 320, ch = c4 * 4;
        const f32x4 baf = *(const f32x4*)(p.in[19] + ch), bxf = *(const f32x4*)(p.in[21] + ch), lf = *(const f32x4*)(p.in[22] + ch);
        const f32x4 bab = *(const f32x4*)(p.in[24] + ch), bxb = *(const f32x4*)(p.in[26] + ch), lb = *(const f32x4*)(p.in[27] + ch);
        f32x4 c8f, c8b;
#pragma unroll
        for (int j = 0; j < 4; ++j) { c8f[j] = 8.f * flog(1.f + fexp(-lf[j])); c8b[j] = 8.f * flog(1.f + fexp(-lb[j])); }
        const unsigned base = ((unsigned)cidx * 64u + half * 32u) * LW + ch;
        f32x4 Af = {1.f, 1.f, 1.f, 1.f}, Uf = {0.f, 0.f, 0.f, 0.f}, Pb = {1.f, 1.f, 1.f, 1.f}, Ub = {0.f, 0.f, 0.f, 0.f};
        u32x4 gfA[4], gbA[4], gfB[4], gbB[4]; u32x2 zcA[4], zcB[4];
#define AGG_LOAD(GF, GB, ZZ, tb) do { _Pragma("unroll") for (int q = 0; q < 4; ++q) { const unsigned o = base + (unsigned)((tb) * 4 + q) * LW; GF[q] = ntload((const u32x4*)(GAf + o)); GB[q] = ntload((const u32x4*)(GAb + o)); ZZ[q] = ntload((const u32x2*)(ZC + o)); } } while (0)
#define AGG_COMP(GF, GB, ZZ) do { _Pragma("unroll") for (int q = 0; q < 4; ++q) { \
                const float z[4] = {lo_bf(ZZ[q].x), hi_bf(ZZ[q].x), lo_bf(ZZ[q].y), hi_bf(ZZ[q].y)}; \
                _Pragma("unroll") for (int j = 0; j < 4; ++j) { float a, u; \
                    gate_au(GF[q][j], z[j], baf[j], bxf[j], c8f[j], a, u); Uf[j] = a * Uf[j] + u; Af[j] *= a; \
                    gate_au(GB[q][j], z[j], bab[j], bxb[j], c8b[j], a, u); Ub[j] += Pb[j] * u; Pb[j] *= a; } } } while (0)
        AGG_LOAD(gfA, gbA, zcA, 0);
        for (int tb = 0; tb < 8; tb += 2) {
            AGG_LOAD(gfB, gbB, zcB, tb + 1);
            AGG_COMP(gfA, gbA, zcA);
            if (tb + 2 < 8) AGG_LOAD(gfA, gbA, zcA, tb + 2);
            AGG_COMP(gfB, gbB, zcB);
        }
#undef AGG_LOAD
#undef AGG_COMP
        f32x4 Af1, Uf1, Pb1, Ub1;
#pragma unroll
        for (int j = 0; j < 4; ++j) { Af1[j] = __shfl_xor(Af[j], 1); Uf1[j] = __shfl_xor(Uf[j], 1); Pb1[j] = __shfl_xor(Pb[j], 1); Ub1[j] = __shfl_xor(Ub[j], 1); }
        if (half == 0) {
            f32x4 A, U, P, UB;
#pragma unroll
            for (int j = 0; j < 4; ++j) { A[j] = Af[j] * Af1[j]; U[j] = Af1[j] * Uf[j] + Uf1[j]; P[j] = Pb[j] * Pb1[j]; UB[j] = Ub[j] + Pb[j] * Ub1[j]; }
            const size_t o = (size_t)cidx * LW + ch;
            *(f32x4*)(CA + o) = A; *(f32x4*)(CU + o) = U; *(f32x4*)(CA + (size_t)NCH * LW + o) = P; *(f32x4*)(CU + (size_t)NCH * LW + o) = UB;
        }
    }
}
DI void phase_lru_carry(const Params& p) {
    const float* CA = (const float*)(p.ws + OFF_CA); const float* CU = (const float*)(p.ws + OFF_CU); float* HS = (float*)(p.ws + OFF_HS);
    for (int idx = blockIdx.x * 512 + threadIdx.x; idx < 4 * 2 * LW; idx += gridDim.x * 512) {
        const int ch = idx % LW, dir = (idx / LW) & 1, b = idx / (2 * LW);
        float h = 0.f;
        for (int s0 = 0; s0 < 132; s0 += 12) {
            size_t o[12]; float a[12], u[12];
#pragma unroll
            for (int q = 0; q < 12; ++q) { const int s = s0 + q; const int cidx = s < 4 ? 512 + 4 * b + (dir ? 3 - s : s) : 128 * b + (dir ? 127 - (s - 4) : (s - 4));
                o[q] = ((size_t)dir * NCH + cidx) * LW + ch; a[q] = CA[o[q]]; u[q] = CU[o[q]]; }
#pragma unroll
            for (int q = 0; q < 12; ++q) { HS[o[q]] = h; h = a[q] * h + u[q]; }
        }
    }
}
DI void phase_lru_apply(const Params& p, unsigned char* shm, float* outbuf) {
    const int tid = threadIdx.x;
    float* hf = (float*)shm;
    const unsigned* GAf = (const unsigned*)(p.ws + OFF_AU); const unsigned* GAb = GAf + (size_t)M * LW;
    const float* HS = (const float*)(p.ws + OFF_HS);
    const u16* G2 = (const u16*)(p.ws + OFF_G2); u16* ZA = (u16*)outbuf;
    for (int wi = blockIdx.x; wi < 1280; wi += gridDim.x) {
        const int item = wi * 2 + (tid >> 8), cidx = item / 5, ch = (item % 5) * 256 + (tid & 255);
        const unsigned base = (unsigned)cidx * 64u * LW + ch;
        const float baf = p.in[19][ch], bxf = p.in[21][ch], c8f = 8.f * flog(1.f + fexp(-p.in[22][ch]));
        const float bab = p.in[24][ch], bxb = p.in[26][ch], c8b = 8.f * flog(1.f + fexp(-p.in[27][ch]));
        float h = HS[(size_t)cidx * LW + ch];
        const float hb0 = HS[((size_t)NCH + cidx) * LW + ch];
        for (int tb = 0; tb < 2; ++tb) {
            unsigned w[32]; u16 z[32];
#pragma unroll
            for (int q = 0; q < 32; ++q) { const unsigned o = base + (unsigned)(tb * 32 + q) * LW; w[q] = ntload(GAf + o); z[q] = ZA[o]; }
#pragma unroll
            for (int q = 0; q < 32; ++q) { float a, u; gate_au(w[q], bf2f(z[q]), baf, bxf, c8f, a, u); h = a * h + u; hf[(tb * 32 + q) * 512 + tid] = h; }
        }
        h = hb0;
        for (int tb = 3; tb >= 0; --tb) {
            unsigned w[16]; u16 z[16], g[16];
#pragma unroll
            for (int q = 0; q < 16; ++q) { const unsigned o = base + (unsigned)(tb * 16 + q) * LW; w[q] = ntload(GAb + o); z[q] = ntload(ZA + o); g[q] = ntload(G2 + o); }
#pragma unroll
            for (int q = 15; q >= 0; --q) { float a, u; gate_au(w[q], bf2f(z[q]), bab, bxb, c8b, a, u); h = a * h + u;
                const float tot = hf[(tb * 16 + q) * 512 + tid] + h;
                ZA[base + (unsigned)(tb * 16 + q) * LW] = f2bf(tot * silu_f(bf2f(g[q]))); }
        }
    }
}

DI void phase_final(const Params& p) {
    const int wave = threadIdx.x >> 6, lane = threadIdx.x & 63;
    const float* MOD = (const float*)(p.ws + OFF_MOD);
    const u16* Y = (const u16*)(p.ws + OFF_Y); const u16* Y2 = (const u16*)(p.ws + OFF_Y2);
    for (int row = blockIdx.x * 16 + wave * 2; row < MX; row += gridDim.x * 16) {
        const int vec = row >> 13;
        const float* gt0 = MOD + (size_t)vec * 3072 + 2048; const float* gt1 = MOD + (size_t)(5 + vec) * 3072 + 2048;
        f32x4 v[2][4]; u32x2 yy[2][4], zz[2][4];
#pragma unroll
        for (int r = 0; r < 2; ++r) { const float* src = p.in[0] + (size_t)(row + r) * D; const size_t prow = (size_t)row_perm(row + r);
#pragma unroll
            for (int i = 0; i < 4; ++i) { const int c = i * 256 + lane * 4; v[r][i] = ntload((const f32x4*)(src + c));
                yy[r][i] = ntload((const u32x2*)(Y + (size_t)(row + r) * D + c)); zz[r][i] = ntload((const u32x2*)(Y2 + prow * D + c)); } }
        f32x4 y[2][4], y2[2][4]; float rsy[2], rs2[2];
#pragma unroll
        for (int r = 0; r < 2; ++r) { float ssy = 0.f, ss2 = 0.f;
#pragma unroll
            for (int i = 0; i < 4; ++i) { y[r][i] = (f32x4){lo_bf(yy[r][i].x), hi_bf(yy[r][i].x), lo_bf(yy[r][i].y), hi_bf(yy[r][i].y)};
                y2[r][i] = (f32x4){lo_bf(zz[r][i].x), hi_bf(zz[r][i].x), lo_bf(zz[r][i].y), hi_bf(zz[r][i].y)};
#pragma unroll
                for (int j = 0; j < 4; ++j) { ssy += y[r][i][j] * y[r][i][j]; ss2 += y2[r][i][j] * y2[r][i][j]; } }
            rsy[r] = rsqrtf(wave_sum(ssy) * (1.f / 1024.f) + 1e-6f); rs2[r] = rsqrtf(wave_sum(ss2) * (1.f / 1024.f) + 1e-6f); }
#pragma unroll
        for (int i = 0; i < 4; ++i) { const int c = i * 256 + lane * 4;
            const f32x4 np0 = *(const f32x4*)(p.in[7] + c), np1 = *(const f32x4*)(p.in[7] + 1024 + c), g0 = *(const f32x4*)(gt0 + c), g1 = *(const f32x4*)(gt1 + c);
#pragma unroll
            for (int r = 0; r < 2; ++r) { f32x4 o;
#pragma unroll
                for (int j = 0; j < 4; ++j) { const float x1 = v[r][i][j] + g0[j] * (y[r][i][j] * rsy[r] * np0[j]); o[j] = x1 + g1[j] * (y2[r][i][j] * rs2[r] * np1[j]); }
                ntstore(o, (f32x4*)(p.out + (size_t)(row + r) * D + c)); } }
    }
}


#define XB_TMO      128
#define XB_XCNT(j)  (256  + 64 * (j))
#define XB_XSUB(j)  (1280 + 64 * (j))
#define XB_XGEN(j)  (2304 + 64 * (j))
#define XB_TOP      3328
#define XB_TOPGEN   3392
#define XCD_BAR_WORDS 3456
#define XB_SPIN_CAP (1u << 18)
DI unsigned xb_ld(unsigned* p)              { return __hip_atomic_load(p, __ATOMIC_RELAXED, __HIP_MEMORY_SCOPE_AGENT); }
DI unsigned xb_add(unsigned* p, unsigned v) { return __hip_atomic_fetch_add(p, v, __ATOMIC_RELAXED, __HIP_MEMORY_SCOPE_AGENT); }
DI unsigned xb_xcc_id() { return (unsigned)__builtin_amdgcn_s_getreg((3 << 11) | 20) & 0xFu; }
#define XB_SPIN(cond, bar) do { unsigned _sp = 0; while (cond) { __builtin_amdgcn_s_sleep(1); \
    if ((++_sp & 255u) == 0u) { if (xb_ld(&(bar)[XB_TMO])) break; if (_sp > XB_SPIN_CAP) { atomicAdd(&(bar)[XB_TMO], 1u); break; } } } } while (0)
struct XcdBarrier { unsigned* bar; unsigned x; volatile LAS unsigned* st; };
DI XcdBarrier xcd_barrier_post(unsigned* bar, volatile LAS unsigned* st) {
    XcdBarrier b; b.bar = bar; b.x = xb_xcc_id(); b.st = st;
    if (threadIdx.x == 0) (void)xb_add(&bar[XB_XCNT(b.x)], 1u);
    return b;
}
DI void xcd_barrier_complete(unsigned* bar, unsigned x, unsigned& nloc, unsigned& nx) {
    const unsigned G = gridDim.x * gridDim.y * gridDim.z;
    unsigned sum, cnt, mine, sp = 0u;
    for (;;) {
        sum = 0u; cnt = 0u; mine = 0u;
#pragma unroll
        for (unsigned j = 0; j < 16; ++j) { const unsigned c = xb_ld(&bar[XB_XCNT(j)]); sum += c; cnt += (c > 0u) ? 1u : 0u; mine = (j == x) ? c : mine; }
        if (sum == G) break;
        __builtin_amdgcn_s_sleep(1);
        if ((++sp & 255u) == 0u) { if (xb_ld(&bar[XB_TMO])) break; if (sp > XB_SPIN_CAP) { atomicAdd(&bar[XB_TMO], 1u); break; } }
    }
    nloc = mine > 0u ? mine : 1u; nx = cnt > 0u ? cnt : 1u;
}
DI void xcd_barrier(const XcdBarrier& b) {
    asm volatile("s_waitcnt vmcnt(0)" ::: "memory");
    __syncthreads();
    if (threadIdx.x == 0) {
        unsigned* bar = b.bar;
        __builtin_amdgcn_s_waitcnt(0);
        unsigned nloc = b.st[0], nx = b.st[1];
        if (nloc == 0u) { xcd_barrier_complete(bar, b.x, nloc, nx); b.st[0] = nloc; b.st[1] = nx; }
        const unsigned old = xb_add(&bar[XB_XSUB(b.x)], 1u);
        const unsigned gen = old / nloc;
        if (old + 1u == (gen + 1u) * nloc) {
            __builtin_amdgcn_fence(__ATOMIC_RELEASE, "agent");
            asm volatile("s_waitcnt vmcnt(0)" ::: "memory");
            const unsigned og = xb_add(&bar[XB_TOP], 1u);
            const unsigned tg = og / nx;
            if (og + 1u == (tg + 1u) * nx) xb_add(&bar[XB_TOPGEN], 1u);
            else XB_SPIN(xb_ld(&bar[XB_TOPGEN]) == tg, bar);
            __builtin_amdgcn_fence(__ATOMIC_ACQUIRE, "agent");
            xb_add(&bar[XB_XGEN(b.x)], 1u);
            asm volatile("s_waitcnt vmcnt(0)" ::: "memory");
        } else {
            XB_SPIN(xb_ld(&bar[XB_XGEN(b.x)]) == gen, bar);
            __builtin_amdgcn_fence(__ATOMIC_ACQUIRE, "agent");
            asm volatile("s_waitcnt vmcnt(0)" ::: "memory");
        }
    }
    __syncthreads();
}

constexpr int NPHASE = 18;
__global__ void __launch_bounds__(512, 2) fwd_megakernel(Params p, int ph0, int ph1) {
    extern __shared__ __attribute__((aligned(16))) unsigned char shm[];
    __shared__ __attribute__((aligned(16))) unsigned xb_words[4];
    LAS unsigned char* lds = (LAS unsigned char*)shm;
    cg::grid_group grid = cg::this_grid();
    XcdBarrier xb; xb.bar = (unsigned*)(p.ws + OFF_BAR); xb.x = 0; xb.st = (volatile LAS unsigned*)xb_words;
    if (ph1 - ph0 > 1) { if (threadIdx.x < 4) xb_words[threadIdx.x] = 0u; __syncthreads(); xb = xcd_barrier_post((unsigned*)(p.ws + OFF_BAR), (volatile LAS unsigned*)xb_words); }
    pg8::StaticOrder S;
#define PHASE(k) if (((PH_MASK >> (k)) & 1) && ph0 <= (k) && (k) < ph1)
#define SYNC(k) if (ph0 <= (k) && (k) + 1 < ph1) { if (ph1 > NPHASE) grid.sync(); else xcd_barrier(xb); }
    PHASE(0) { phase_prep(p, shm); } SYNC(0);
    PHASE(1) {
        if (blockIdx.x < 64 && gridDim.x > 64) phase_transposes(p, shm, blockIdx.x, 64);
        else if (gridDim.x > 64) phase_h0(p, blockIdx.x - 64, gridDim.x - 64);
        else { phase_transposes(p, shm, blockIdx.x, gridDim.x); phase_h0(p, blockIdx.x, gridDim.x); }
    } SYNC(1);
    PHASE(2) {
        pg8::Gemm g = {(const u16*)(p.ws + OFF_R0), (const u16*)(p.ws + OFF_WT1), M, 3328, 1024, 1024, 1024, 0, 0};
        EpiBf16Split E; E.base[0] = (u16*)(p.ws + OFF_R1); E.base[1] = (u16*)(p.ws + OFF_R2); E.base[2] = (u16*)(p.ws + OFF_R3); E.split_tiles = 4; E.ldc = 1024; E.lr = (float*)(p.ws + OFF_LR); E.lr_tile = 12;
        S.init(g.M, g.N, gridDim.x, blockIdx.x); pg8::gemm_phase(lds, g, S, E);
    } SYNC(2);
    PHASE(3) { phase_gla_chunk(p, shm, p.out); } SYNC(3);
    PHASE(4) { phase_gla_seq<0>(p, shm, p.out); } SYNC(4);
    PHASE(5) { phase_gla_combine(p, MX, M, blockIdx.x, gridDim.x); } SYNC(5);
    PHASE(6) {
        if (blockIdx.x < 16) {
            pg8::Gemm g = {(const u16*)(p.ws + OFF_R4) + (size_t)MX * 1024, (const u16*)(p.ws + OFF_WT2), MC, 1024, 1024, 1024, 1024, 0, 0};
            EpiBf16Split E; E.base[0] = E.base[1] = E.base[2] = (u16*)(p.ws + OFF_Y); E.split_tiles = 64; E.ldc = 1024; E.lr = nullptr; E.lr_tile = -1; E.row_base = MX;
            S.init(g.M, g.N, 16, blockIdx.x); pg8::gemm_phase(lds, g, S, E);
        } else phase_gla_combine(p, 0, MX, blockIdx.x - 16, gridDim.x - 16);
    } SYNC(6);
    PHASE(7) {
        pg8::Gemm g = {(const u16*)(p.ws + OFF_R4), (const u16*)(p.ws + OFF_WT2), MX, 1024, 1024, 1024, 1024, 0, 0};
        EpiBf16Split E; E.base[0] = E.base[1] = E.base[2] = (u16*)(p.ws + OFF_Y); E.split_tiles = 64; E.ldc = 1024; E.lr = nullptr; E.lr_tile = -1;
        S.init(g.M, g.N, gridDim.x, blockIdx.x); pg8::gemm_phase(lds, g, S, E);
    } SYNC(7);
    PHASE(8) { phase_h1(p, MX, M, blockIdx.x, gridDim.x); } SYNC(8);
    PHASE(9) {
        if (blockIdx.x < 40) {
            pg8::Gemm g = {(const u16*)(p.ws + OFF_R0) + (size_t)MX * 1024, (const u16*)(p.ws + OFF_WT3), MC, 2560, 1024, 1024, 1024, 0, 0};
            EpiBf16Split E; E.base[0] = (u16*)(p.ws + OFF_Z); E.base[1] = E.base[2] = (u16*)(p.ws + OFF_G2); E.split_tiles = 5; E.ldc = 1280; E.lr = nullptr; E.lr_tile = -1; E.row_base = MX;
            S.init(g.M, g.N, 40, blockIdx.x); pg8::gemm_phase(lds, g, S, E);
        } else phase_h1(p, 0, MX, blockIdx.x - 40, gridDim.x - 40);
    } SYNC(9);
    PHASE(10) {
        pg8::Gemm g = {(const u16*)(p.ws + OFF_R0), (const u16*)(p.ws + OFF_WT3), MX, 2560, 1024, 1024, 1024, 0, 0};
        EpiBf16Split E; E.base[0] = (u16*)(p.ws + OFF_Z); E.base[1] = E.base[2] = (u16*)(p.ws + OFF_G2); E.split_tiles = 5; E.ldc = 1280; E.lr = nullptr; E.lr_tile = -1;
        S.init(g.M, g.N, gridDim.x, blockIdx.x); pg8::gemm_phase(lds, g, S, E);
    } SYNC(10);
    PHASE(11) { phase_conv(p, p.out); } SYNC(11);
    PHASE(12) {
        pg8::Gemm g = {(const u16*)p.out, (const u16*)(p.ws + OFF_WT4), M, 5120, 256, 1280, 256, 2, 512};
        EpiPair E; E.GA = (unsigned*)(p.ws + OFF_AU);
        S.init(g.M, g.N, gridDim.x, blockIdx.x); pg8::gemm_phase(lds, g, S, E);
    } SYNC(12);
    PHASE(13) { phase_lru_agg(p, p.out); } SYNC(13);
    PHASE(14) { phase_lru_carry(p); } SYNC(14);
    PHASE(15) { phase_lru_apply(p, shm, p.out); } SYNC(15);
    PHASE(16) {
        pg8::Gemm g = {(const u16*)p.out, (const u16*)(p.ws + OFF_WT5), MX, 1024, 1280, 1280, 1280, 0, 0};
        EpiBf16Split E; E.base[0] = E.base[1] = E.base[2] = (u16*)(p.ws + OFF_Y2); E.split_tiles = 64; E.ldc = 1024; E.lr = nullptr; E.lr_tile = -1;
        S.init(g.M, g.N, gridDim.x, blockIdx.x); pg8::gemm_phase(lds, g, S, E);
    } SYNC(16);
    PHASE(17) { phase_final(p); }
#undef PHASE
#undef SYNC
}

extern "C" void kernel_launch(void* const* d_in, const int* in_sizes, int n_in, void* d_out, int out_size, void* d_ws, size_t ws_size, hipStream_t stream) {
    constexpr size_t kDynLds = 131072;
    static int grid_blocks = 0;
    if (!grid_blocks) {
        hipFuncSetAttribute((const void*)fwd_megakernel, hipFuncAttributeMaxDynamicSharedMemorySize, (int)kDynLds);
        int dev = 0, cus = 0, per_cu = 0;
        hipGetDevice(&dev);
        hipDeviceGetAttribute(&cus, hipDeviceAttributeMultiprocessorCount, dev);
        hipOccupancyMaxActiveBlocksPerMultiprocessor(&per_cu, fwd_megakernel, 512, kDynLds);
        if (per_cu < 1) per_cu = 1;
        grid_blocks = cus * 1;
    }
    Params p{};
    for (int i = 0; i < 29; ++i) p.in[i] = (const float*)d_in[i];
    p.out = (float*)d_out; p.ws = (unsigned char*)d_ws;
#if MULTI_LAUNCH
    for (int k = 0; k < NPHASE; ++k) for (int rep = 0; rep <= ((REP_MASK >> k) & 1); ++rep) fwd_megakernel<<<dim3(grid_blocks), dim3(512), kDynLds, stream>>>(p, k, k + 1);
#else
    int ph0 = 0, ph1 = NPHASE;
    (void)hipMemsetAsync((unsigned char*)d_ws + OFF_BAR, 0, XCD_BAR_WORDS * sizeof(unsigned), stream);
    void* args[] = {&p, &ph0, &ph1};
    hipError_t e = hipLaunchCooperativeKernel((void*)fwd_megakernel, dim3(grid_blocks), dim3(512), args, kDynLds, stream);
    if (e != hipSuccess) fprintf(stderr, "cooperative launch failed: %s (grid %d)\n", hipGetErrorString(e), grid_blocks);
#endif
}
```
